# Optimizing an MI355X kernel written in HIP

```python
import math
import jax, jax.numpy as jnp
from jax import lax
import numpy as np


D_MODEL = 1024
BATCH = 16
SEQ = 256
DEPTH = 2
DEC_BATCH = 4
DEC_SEQ = 2048
PAST_LEN = 256

GRID_W = 64
EPS = 1e-6
RET_HEADS = 4
RET_HEAD_DIM = 128
RET_WIDTH = RET_HEADS * RET_HEAD_DIM
RET_CHUNK = 128
ROPE_BASE = 10000.0
HY_WIDTH = 512
HY_ORDER = 2
HY_SHORT = 3
HY_EMB = 33
HY_FFN = 64
HY_SHORT_DECAY_PCT = 0.3
HY_LONG_DECAY_PCT = 1.5
HY_TARGET = 1e-2
LRU_WIDTH = 512
LRU_BLOCKS = 8
LRU_BLOCK_DIM = LRU_WIDTH // LRU_BLOCKS
LRU_CONV = 4
LRU_C = 8.0
D_MIX = RET_WIDTH + HY_WIDTH + LRU_WIDTH
D_IN = 4 * RET_WIDTH + 4 * HY_WIDTH + 2 * LRU_WIDTH

kernel_name = "hybrid_ret_hyena_rglru_diffusion_step"

F32 = jnp.float32


def rmsnorm(x, g):
    xf = x.astype(F32)
    y = xf * lax.rsqrt(jnp.mean(xf * xf, axis=-1, keepdims=True) + EPS)
    return (y * g.astype(F32)).astype(x.dtype)


def grid_rope(rows):
    row = jnp.repeat(jnp.arange(rows, dtype=F32), GRID_W)
    col = jnp.broadcast_to(jnp.arange(GRID_W, dtype=F32)[None, :], (rows, GRID_W)).reshape(-1)
    n_f = RET_HEAD_DIM // 4
    inv = ROPE_BASE ** (-jnp.arange(n_f, dtype=F32) / n_f)
    ang = jnp.concatenate([row[:, None] * inv[None], col[:, None] * inv[None]], axis=-1)
    return jnp.cos(ang), jnp.sin(ang)


def apply_rope(x, cos, sin):
    half = RET_HEAD_DIM // 2
    xa, xb = x[..., :half], x[..., half:]
    c = cos[None, :, None, :]
    s = sin[None, :, None, :]
    return jnp.concatenate([xa * c - xb * s, xa * s + xb * c], axis=-1)


def depthwise_conv(u, w, b, left):
    K, C = w.shape
    y = lax.conv_general_dilated(u, w[:, None, :].astype(u.dtype), (1,), [(left, K - 1 - left)],
                                 dimension_numbers=('NWC', 'WIO', 'NWC'), feature_group_count=C)
    return y + b.astype(u.dtype)


def retention_dir(q, k, v, log_gamma, state0):
    B, L, H, dk = q.shape
    C = RET_CHUNK
    n = L // C
    qc = q.reshape(B, n, C, H, dk)
    kc = k.reshape(B, n, C, H, dk)
    vc = v.reshape(B, n, C, H, -1)
    idx = jnp.arange(C, dtype=F32)
    diff = idx[:, None] - idx[None, :]
    dmat = jnp.where(diff >= 0, jnp.exp(log_gamma[:, None, None] * jnp.maximum(diff, 0.0)[None]), 0.0)
    scores = jnp.einsum('bnihd,bnjhd->bnhij', qc, kc) * dmat[None, None]
    inner = jnp.einsum('bnhij,bnjhe->bnihe', scores, vc)
    zeta = jnp.exp(log_gamma[:, None] * (C - 1 - idx)[None, :])
    kv = jnp.einsum('bnjhd,hj,bnjhe->bnhde', kc, zeta, vc)
    chunk_decay = jnp.exp(log_gamma * C)[None, :, None, None]

    def step(R, kv_i):
        return chunk_decay * R + kv_i, R

    R_final, R_prev = lax.scan(step, state0, jnp.moveaxis(kv, 1, 0))
    R_prev = jnp.moveaxis(R_prev, 0, 1)
    xi = jnp.exp(log_gamma[:, None] * (idx + 1.0)[None, :])
    cross = jnp.einsum('bnihd,hi,bnhde->bnihe', qc, xi, R_prev)
    return (inner + cross).reshape(B, L, H, -1), R_final


def retention_mixer(q, k, v, decay_logit, state0):
    B, L, H, _ = q.shape
    log_g = jax.nn.log_sigmoid(decay_logit.astype(F32))
    s0 = state0.astype(F32)
    of, sf = retention_dir(q, k, v, log_g[0], s0[:, 0])
    ob, sb = retention_dir(q[:, ::-1], k[:, ::-1], v[:, ::-1], log_g[1], s0[:, 1])
    out = of + ob[:, ::-1]
    out = out * lax.rsqrt(jnp.mean(out * out, axis=-1, keepdims=True) + EPS)
    return out.reshape(B, L, RET_WIDTH), jnp.stack([sf, sb], axis=1)


def hyena_filters(L, w1, b1, w2, b2, w3, freq):
    t = jnp.linspace(0.0, 1.0, L, dtype=F32)[:, None]
    n_bands = (HY_EMB - 1) // 2
    f = jnp.linspace(1e-4, n_bands - 1, n_bands, dtype=F32)
    ang = (2.0 * math.pi / L) * jnp.arange(L, dtype=F32)[:, None] * f[None, :]
    z = jnp.concatenate([t, jnp.cos(ang), -jnp.sin(ang)], axis=-1)
    fr = freq.astype(F32)
    hid = jnp.sin(fr[0] * (z @ w1.astype(F32) + b1.astype(F32)))
    hid = jnp.sin(fr[1] * (hid @ w2.astype(F32) + b2.astype(F32)))
    h = (hid @ w3.astype(F32)).reshape(L, HY_ORDER, 2, HY_WIDTH)
    min_decay = math.log(HY_TARGET) / HY_LONG_DECAY_PCT
    max_decay = math.log(HY_TARGET) / HY_SHORT_DECAY_PCT
    deltas = jnp.abs(jnp.linspace(min_decay, max_decay, HY_WIDTH, dtype=F32))
    h = h * jnp.exp(-t * deltas[None, :])[:, None, None, :]
    return h / (jnp.sum(jnp.abs(h), axis=0, keepdims=True) + EPS)


def long_conv_bidir(u, hf, hb, bias):
    L = u.shape[1]
    n = 2 * L
    U = jnp.fft.rfft(u, n=n, axis=1)
    Hs = jnp.fft.rfft(hf, n=n, axis=0) + jnp.conj(jnp.fft.rfft(hb, n=n, axis=0))
    y = jnp.fft.irfft(U * Hs[None], n=n, axis=1)[:, :L]
    return y + u * bias


def hyena_mixer(u3, conv_w, conv_b, filt, bias):
    u = depthwise_conv(u3, conv_w, conv_b, (HY_SHORT - 1) // 2).astype(F32)
    v, x1, x2 = jnp.split(u, 3, axis=-1)
    bias = bias.astype(F32)
    z = x1 * long_conv_bidir(v, filt[:, 0, 0], filt[:, 0, 1], bias[0])
    z = x2 * long_conv_bidir(z, filt[:, 1, 0], filt[:, 1, 1], bias[1])
    return z


def _lru_combine(left, right):
    a1, b1 = left
    a2, b2 = right
    return a1 * a2, a2 * b1 + b2


def rglru_dir(u, gw, gb, lam, h0):
    B, L, W = u.shape
    ub = u.reshape(B, L, LRU_BLOCKS, LRU_BLOCK_DIM)
    g = jnp.einsum('blnd,knde->kblne', ub, gw).reshape(2, B, L, W) + gb[:, None, None, :]
    r = jax.nn.sigmoid(g[0])
    i = jax.nn.sigmoid(g[1])
    log_a = -LRU_C * r * jax.nn.softplus(-lam)[None, None, :]
    a = jnp.exp(log_a)
    b = jnp.sqrt(-jnp.expm1(2.0 * log_a)) * (i * u)
    a_cum, b_cum = lax.associative_scan(_lru_combine, (a, b), axis=1)
    h = b_cum + a_cum * h0[:, None, :]
    return h, h[:, -1]


def rglru_mixer(x_in, conv_w, conv_b, gw, gb, lam, h0):
    u = depthwise_conv(x_in, conv_w, conv_b, LRU_CONV // 2).astype(F32)
    gw = gw.astype(F32)
    gb = gb.astype(F32)
    lam = lam.astype(F32)
    h0 = h0.astype(F32)
    hf, sf = rglru_dir(u, gw[0], gb[0], lam[0], h0[:, 0])
    hb, sb = rglru_dir(u[:, ::-1], gw[1], gb[1], lam[1], h0[:, 1])
    return hf + hb[:, ::-1], jnp.stack([sf, sb], axis=1)


def mixer_layer(x, mod, ret_s0, lru_s0, rope, filt, norm_g, w_in, ret_logit, hy_conv_w, hy_conv_b,
                hy_bias, lru_conv_w, lru_conv_b, lru_gw, lru_gb, lru_lam, w_out):
    B, L, _ = x.shape
    shift, scale, gate = jnp.split(mod, 3, axis=-1)
    h = rmsnorm(x, norm_g) * (1 + scale) + shift
    z = h @ w_in
    o1 = 4 * RET_WIDTH
    o2 = o1 + 4 * HY_WIDTH
    zr, zh, zl = z[..., :o1], z[..., o1:o2], z[..., o2:]
    q, k, v, g_r = jnp.split(zr.astype(F32), 4, axis=-1)
    q = q.reshape(B, L, RET_HEADS, RET_HEAD_DIM)
    k = k.reshape(B, L, RET_HEADS, RET_HEAD_DIM) * (RET_HEAD_DIM ** -0.5)
    v = v.reshape(B, L, RET_HEADS, RET_HEAD_DIM)
    if rope is not None:
        q = apply_rope(q, rope[0], rope[1])
        k = apply_rope(k, rope[0], rope[1])
    ret_out, ret_s = retention_mixer(q, k, v, ret_logit, ret_s0)
    hy_out = hyena_mixer(zh[..., :3 * HY_WIDTH], hy_conv_w, hy_conv_b, filt, hy_bias)
    g_h = zh[..., 3 * HY_WIDTH:].astype(F32)
    lru_out, lru_s = rglru_mixer(zl[..., :LRU_WIDTH], lru_conv_w, lru_conv_b, lru_gw, lru_gb, lru_lam, lru_s0)
    g_l = zl[..., LRU_WIDTH:].astype(F32)
    y = jnp.concatenate([ret_out * jax.nn.silu(g_r), hy_out * jax.nn.silu(g_h),
                         lru_out * jax.nn.silu(g_l)], axis=-1).astype(x.dtype)
    return x + gate * (y @ w_out), ret_s, lru_s


def setup_inputs(seed: int = 0) -> dict:
    key = jax.random.key(seed)
    ks = jax.random.split(key, 32)
    nrm = lambda i, shape: jax.random.normal(ks[i], shape, dtype=F32)
    base_logit = jnp.log(2.0 ** (5.0 + jnp.arange(RET_HEADS, dtype=F32)) - 1.0)
    ret_decay_logit = base_logit[None, None, :] + 0.1 * nrm(10, (DEPTH, 2, RET_HEADS))
    a_target = jax.random.uniform(ks[11], (DEPTH, 2, LRU_WIDTH), dtype=F32, minval=0.9, maxval=0.999)
    sp = -jnp.log(a_target) / LRU_C
    lru_lambda = -jnp.log(jnp.expm1(sp))
    return {
        "x_prompt": nrm(0, (BATCH, SEQ, D_MODEL)),
        "x_sample": nrm(1, (DEC_BATCH, DEC_SEQ, D_MODEL)),
        "state_ret": 0.5 * nrm(2, (DEC_BATCH, DEPTH, 2, RET_HEADS, RET_HEAD_DIM, RET_HEAD_DIM)),
        "state_lru": 0.5 * nrm(3, (DEC_BATCH, DEPTH, 2, LRU_WIDTH)),
        "c": nrm(4, (DEC_BATCH, D_MODEL)),
        "c_ctx": nrm(5, (D_MODEL,)),
        "norm_g": 1.0 + 0.1 * nrm(6, (DEPTH, D_MODEL)),
        "ada_w": 0.5 * D_MODEL ** -0.5 * nrm(7, (DEPTH, D_MODEL, 3 * D_MODEL)),
        "ada_b": 0.02 * nrm(8, (DEPTH, 3 * D_MODEL)),
        "w_in": D_MODEL ** -0.5 * nrm(9, (DEPTH, D_MODEL, D_IN)),
        "ret_decay_logit": ret_decay_logit,
        "hy_conv_w": HY_SHORT ** -0.5 * nrm(12, (DEPTH, HY_SHORT, 3 * HY_WIDTH)),
        "hy_conv_b": 0.02 * nrm(13, (DEPTH, 3 * HY_WIDTH)),
        "hy_ffn_w1": HY_EMB ** -0.5 * nrm(14, (DEPTH, HY_EMB, HY_FFN)),
        "hy_ffn_b1": 0.02 * nrm(15, (DEPTH, HY_FFN)),
        "hy_ffn_w2": HY_FFN ** -0.5 * nrm(16, (DEPTH, HY_FFN, HY_FFN)),
        "hy_ffn_b2": 0.02 * nrm(17, (DEPTH, HY_FFN)),
        "hy_ffn_w3": HY_FFN ** -0.5 * nrm(18, (DEPTH, HY_FFN, HY_ORDER * 2 * HY_WIDTH)),
        "hy_freq": 1.0 + 0.1 * nrm(19, (DEPTH, 2, HY_FFN)),
        "hy_bias": 0.1 * nrm(20, (DEPTH, HY_ORDER, HY_WIDTH)),
        "lru_conv_w": 0.5 * nrm(21, (DEPTH, LRU_CONV, LRU_WIDTH)),
        "lru_conv_b": 0.02 * nrm(22, (DEPTH, LRU_WIDTH)),
        "lru_gate_w": LRU_BLOCK_DIM ** -0.5 * nrm(23, (DEPTH, 2, 2, LRU_BLOCKS, LRU_BLOCK_DIM, LRU_BLOCK_DIM)),
        "lru_gate_b": 0.02 * nrm(24, (DEPTH, 2, 2, LRU_WIDTH)),
        "lru_lambda": lru_lambda,
        "w_out": D_MIX ** -0.5 * nrm(25, (DEPTH, D_MIX, D_MODEL)),
        "final_g": 1.0 + 0.1 * nrm(26, (D_MODEL,)),
    }


def reference(x_prompt, x_sample, state_ret, state_lru, c, c_ctx, norm_g, ada_w, ada_b, w_in,
              ret_decay_logit, hy_conv_w, hy_conv_b, hy_ffn_w1, hy_ffn_b1, hy_ffn_w2, hy_ffn_b2,
              hy_ffn_w3, hy_freq, hy_bias, lru_conv_w, lru_conv_b, lru_gate_w, lru_gate_b,
              lru_lambda, w_out, final_g):
    Bp, Lp, _ = x_prompt.shape
    Bs, Ls, _ = x_sample.shape
    rows = Ls // GRID_W
    rope = grid_rope(rows)
    zero_ret = jnp.zeros((Bp, 2, RET_HEADS, RET_HEAD_DIM, RET_HEAD_DIM), F32)
    zero_lru = jnp.zeros((Bp, 2, LRU_WIDTH), F32)
    xc, xl = x_prompt, x_sample
    new_ret, new_lru = [], []
    for l in range(DEPTH):
        p = (norm_g[l], w_in[l], ret_decay_logit[l], hy_conv_w[l], hy_conv_b[l], hy_bias[l],
             lru_conv_w[l], lru_conv_b[l], lru_gate_w[l], lru_gate_b[l], lru_lambda[l], w_out[l])
        filt_c = hyena_filters(Lp, hy_ffn_w1[l], hy_ffn_b1[l], hy_ffn_w2[l], hy_ffn_b2[l], hy_ffn_w3[l], hy_freq[l])
        filt_l = hyena_filters(Ls, hy_ffn_w1[l], hy_ffn_b1[l], hy_ffn_w2[l], hy_ffn_b2[l], hy_ffn_w3[l], hy_freq[l])
        mod_c = (jax.nn.silu(c_ctx) @ ada_w[l] + ada_b[l])[None, None, :]
        mod_l = (jax.nn.silu(c) @ ada_w[l] + ada_b[l])[:, None, :]
        xc, rs, ls = mixer_layer(xc, mod_c, zero_ret, zero_lru, None, filt_c, *p)
        new_ret.append(rs)
        new_lru.append(ls)
        xl, _, _ = mixer_layer(xl, mod_l, state_ret[:, l], state_lru[:, l], rope, filt_l, *p)
    y_prompt = rmsnorm(xc, final_g)
    y_sample = rmsnorm(xl, final_g)
    new_state_ret = jnp.stack(new_ret, axis=1).astype(x_prompt.dtype)
    new_state_lru = jnp.stack(new_lru, axis=1).astype(x_prompt.dtype)
    return (y_prompt, y_sample, new_state_ret, new_state_lru)
```

```cpp
#include <hip/hip_runtime.h>
#include <hip/hip_bf16.h>
#include <hip/hip_cooperative_groups.h>
#include <cstdio>
#include <type_traits>
namespace cg = cooperative_groups;

#ifndef COOP
#define COOP 1
#endif

typedef unsigned short u16;
using bf16x8 = __attribute__((ext_vector_type(8))) short;
using f32x4 = __attribute__((ext_vector_type(4))) float;
using f32x16 = __attribute__((ext_vector_type(16))) float;
using u32x4 = __attribute__((ext_vector_type(4))) unsigned;
using u32x32 = __attribute__((ext_vector_type(32))) unsigned;
#define DI __device__ __forceinline__

constexpr int D = 1024, MTOK = 12288, MCTX = 4096, DIN = 5120, DMIX = 1536;
constexpr int ZRL_LD = 3072;
constexpr float EPSF = 1e-6f;
constexpr size_t OFF_HY   = 0;
constexpr size_t OFF_ZRL  = OFF_HY   + (size_t)MTOK * 1536 * 2;
constexpr size_t OFF_ZT   = OFF_ZRL  + (size_t)MTOK * ZRL_LD * 2;
constexpr size_t OFF_WIN  = OFF_ZT   + (size_t)2048 * MTOK * 2;
constexpr size_t OFF_WOUT = OFF_WIN  + (size_t)2 * DIN * D * 2;
constexpr size_t OFF_FILT = OFF_WOUT + (size_t)2 * D * DMIX * 2;
constexpr size_t OFF_KV   = OFF_FILT + (size_t)8 * 512 * 2304 * 2;
constexpr size_t OFF_MOD  = OFF_KV   + (size_t)96 * 8 * 16384 * 2;
constexpr size_t OFF_HID2 = OFF_MOD  + (size_t)2 * 5 * 3072 * 4;
constexpr size_t OFF_ROPE = OFF_HID2 + (size_t)2 * 2304 * 64 * 4;
constexpr size_t OFF_GWT  = OFF_ROPE + (size_t)2 * 2048 * 64 * 4;
constexpr size_t OFF_LRUS = OFF_GWT  + (size_t)64 * 4096 * 2;
constexpr size_t OFF_CSUM = OFF_LRUS + (size_t)192 * 2 * 2 * 512 * 4;
constexpr size_t OFF_BAR  = OFF_CSUM + (size_t)2 * 2 * 2048 * 4;
constexpr size_t BAR_BYTES = 3456 * 4;
constexpr size_t OFF_YT   = OFF_BAR + 16384;
constexpr size_t WS_TOTAL = OFF_YT + (size_t)512 * MTOK * 2;

struct Params { const float* in[27]; float* out; char* ws; unsigned* bar; };

enum { I_XP = 0, I_XS, I_SRET, I_SLRU, I_C, I_CCTX, I_NORMG, I_ADAW, I_ADAB, I_WIN, I_RLOGIT, I_HCW, I_HCB,
       I_HW1, I_HB1, I_HW2, I_HB2, I_HW3, I_HFREQ, I_HBIAS, I_LCW, I_LCB, I_LGW, I_LGB, I_LLAM, I_WOUT, I_FING };

constexpr size_t OUT_SRET = (size_t)MTOK * D;
constexpr size_t OUT_SLRU = OUT_SRET + (size_t)16 * 2 * 2 * 4 * 16384;

typedef __bf16 bf16x2_t __attribute__((ext_vector_type(2)));
typedef float f32x2_t __attribute__((ext_vector_type(2)));
DI u16 f2bf(float x) { __bf16 r = (__bf16)x; return __builtin_bit_cast(u16, r); }
DI float bf2f(u16 v) { return __uint_as_float(((unsigned)v) << 16); }
DI unsigned pack2(float a, float b) { f32x2_t v = {a, b}; bf16x2_t r = __builtin_convertvector(v, bf16x2_t); return __builtin_bit_cast(unsigned, r); }
DI float siluf(float x) { return x * __builtin_amdgcn_rcpf(1.f + __expf(-x)); }
DI float sigmf(float x) { return __builtin_amdgcn_rcpf(1.f + __expf(-x)); }
DI int crow(int i, int h) { return (i & 3) + 8 * (i >> 2) + 4 * h; }
DI f32x16 mfma32(bf16x8 a, bf16x8 b, f32x16 c) { return __builtin_amdgcn_mfma_f32_32x32x16_bf16(a, b, c, 0, 0, 0); }
DI f32x4 mfma16(bf16x8 a, bf16x8 b, f32x4 c) { return __builtin_amdgcn_mfma_f32_16x16x32_bf16(a, b, c, 0, 0, 0); }
DI int swz(int row, int col) { return row * 128 + ((((col >> 3) ^ (row & 15)) << 3) | (col & 7)); }
DI int swz64(int row, int col) { return row * 64 + ((((col >> 3) ^ (row & 7)) << 3) | (col & 7)); }
DI bf16x8 ldfrag(const u16* buf, int row, int col8) { return *(const bf16x8*)(buf + swz(row, col8)); }
DI f32x16 zero16() { f32x16 z; for (int i = 0; i < 16; ++i) z[i] = 0.f; return z; }
DI void unpack8(uint4 v, float* f) {
  f[0] = __uint_as_float(v.x << 16); f[1] = __uint_as_float(v.x & 0xffff0000u);
  f[2] = __uint_as_float(v.y << 16); f[3] = __uint_as_float(v.y & 0xffff0000u);
  f[4] = __uint_as_float(v.z << 16); f[5] = __uint_as_float(v.z & 0xffff0000u);
  f[6] = __uint_as_float(v.w << 16); f[7] = __uint_as_float(v.w & 0xffff0000u);
}
DI uint4 pack8(const float* f) { uint4 v; v.x = pack2(f[0], f[1]); v.y = pack2(f[2], f[3]); v.z = pack2(f[4], f[5]); v.w = pack2(f[6], f[7]); return v; }
DI int get_tid() { int t = threadIdx.x; asm volatile("" : "+v"(t)); return t; }
DI u16 get16(const uint4& v, int q) { unsigned wv = (q >> 1) == 0 ? v.x : (q >> 1) == 1 ? v.y : (q >> 1) == 2 ? v.z : v.w; return (u16)((q & 1) ? (wv >> 16) : (wv & 0xffffu)); }
DI unsigned pair16(const uint4& a, const uint4& b, int q) {
  unsigned wa = (q >> 1) == 0 ? a.x : (q >> 1) == 1 ? a.y : (q >> 1) == 2 ? a.z : a.w;
  unsigned wb = (q >> 1) == 0 ? b.x : (q >> 1) == 1 ? b.y : (q >> 1) == 2 ? b.z : b.w;
  return (q & 1) ? ((wa >> 16) | (wb & 0xffff0000u)) : ((wa & 0xffffu) | (wb << 16));
}
DI float logsig(float x) { return -log1pf(expf(-x)); }

DI void transpose_tile(const float* src, int lds_, u16* dst, int ldd, char* smem) {
  float* tile = (float*)smem;
  const int tid = get_tid();
  float4 v[4];
#pragma unroll
  for (int i = 0; i < 4; ++i) {
    int idx = i * 256 + tid; int r = idx >> 4, c4 = idx & 15;
    f32x4 t4 = __builtin_nontemporal_load((const f32x4*)(src + (size_t)r * lds_ + c4 * 4));
    v[i] = make_float4(t4[0], t4[1], t4[2], t4[3]);
  }
#pragma unroll
  for (int i = 0; i < 4; ++i) {
    int idx = i * 256 + tid; int r = idx >> 4, c4 = idx & 15;
    tile[r * 65 + c4 * 4] = v[i].x; tile[r * 65 + c4 * 4 + 1] = v[i].y; tile[r * 65 + c4 * 4 + 2] = v[i].z; tile[r * 65 + c4 * 4 + 3] = v[i].w;
  }
  __syncthreads();
#pragma unroll
  for (int i = 0; i < 2; ++i) {
    int idx = i * 256 + tid; int kc = idx & 7, c = idx >> 3;
    float f[8];
#pragma unroll
    for (int q = 0; q < 8; ++q) f[q] = tile[(kc * 8 + q) * 65 + c];
    *(uint4*)(dst + (size_t)c * ldd + kc * 8) = pack8(f);
  }
  __syncthreads();
}

constexpr int N_TW = 2 * 16 * 80, N_TO = 2 * 24 * 16, N_TG = 64, N_MOD = 384, N_HID = 1152, N_ROPE = 512;
constexpr int PREP_MOD0 = N_TW + N_TO + N_TG, PREP_TOTAL = PREP_MOD0 + N_MOD + N_HID + N_ROPE;
DI void prep_item(const Params& p, int item, char* smem) {
  const int tid = get_tid();
  do {
    int it = item;
    if (it < N_TW) {
      int l = it / 1280, rem = it % 1280, kt = rem / 80, nt = rem % 80;
      transpose_tile(p.in[I_WIN] + ((size_t)l * D + kt * 64) * DIN + nt * 64, DIN,
                     (u16*)(p.ws + OFF_WIN) + ((size_t)l * DIN + nt * 64) * D + kt * 64, D, smem);
      continue;
    }
    it -= N_TW;
    if (it < N_TO) {
      int l = it / 384, rem = it % 384, kt = rem / 16, nt = rem % 16;
      transpose_tile(p.in[I_WOUT] + ((size_t)l * DMIX + kt * 64) * D + nt * 64, D,
                     (u16*)(p.ws + OFF_WOUT) + ((size_t)l * D + nt * 64) * DMIX + kt * 64, DMIX, smem);
      continue;
    }
    it -= N_TO;
    if (it < N_TG) {
      transpose_tile(p.in[I_LGW] + (size_t)it * 4096, 64, (u16*)(p.ws + OFF_GWT) + (size_t)it * 4096, 64, smem);
      continue;
    }
    it -= N_TG;
    if (it < N_MOD) {
      int l = it / 192, j0 = (it % 192) * 16;
      float* sc = (float*)smem;
      float* red = sc + 5 * 1024;
      for (int idx = tid; idx < 5120; idx += 256) {
        int bb = idx >> 10, k = idx & 1023;
        float cv = bb == 0 ? p.in[I_CCTX][k] : p.in[I_C][(bb - 1) * 1024 + k];
        sc[idx] = cv / (1.f + expf(-cv));
      }
      __syncthreads();
      int col = tid & 15, kp = tid >> 4;
      float a0 = 0, a1 = 0, a2 = 0, a3 = 0, a4 = 0;
      const float* wp = p.in[I_ADAW] + ((size_t)l * D + kp * 64) * 3072 + j0 + col;
#pragma unroll 16
      for (int k = 0; k < 64; ++k) {
        float w = __builtin_nontemporal_load(wp + (size_t)k * 3072); int kk = kp * 64 + k;
        a0 += sc[kk] * w; a1 += sc[1024 + kk] * w; a2 += sc[2048 + kk] * w; a3 += sc[3072 + kk] * w; a4 += sc[4096 + kk] * w;
      }
      red[(kp * 5 + 0) * 16 + col] = a0; red[(kp * 5 + 1) * 16 + col] = a1; red[(kp * 5 + 2) * 16 + col] = a2;
      red[(kp * 5 + 3) * 16 + col] = a3; red[(kp * 5 + 4) * 16 + col] = a4;
      __syncthreads();
      if (tid < 80) {
        int bb = tid >> 4, cc = tid & 15; float sm = 0.f;
#pragma unroll
        for (int q = 0; q < 16; ++q) sm += red[(q * 5 + bb) * 16 + cc];
        ((float*)(p.ws + OFF_MOD))[(l * 5 + bb) * 3072 + j0 + cc] = sm + p.in[I_ADAB][l * 3072 + j0 + cc];
      }
      __syncthreads();
      continue;
    }
    it -= N_MOD;
    if (it < N_HID) {
      int l = it / 576, rg = it % 576;
      int rr = rg * 4 + (tid >> 6), o = tid & 63, rw = tid >> 6;
      int L = rr < 256 ? 256 : 2048, pos = rr < 256 ? rr : rr - 256;
      float* zb = (float*)smem;
      float* h1 = zb + 4 * 36;
      if (o < 33) {
        float v;
        if (o == 0) v = (float)pos / (float)(L - 1);
        else {
          int i = (o - 1) & 15;
          float f = 1e-4f + (float)i * ((15.f - 1e-4f) / 15.f);
          float w0 = (L == 256) ? (float)(6.283185307179586 / 256.0) : (float)(6.283185307179586 / 2048.0);
          float ang = (w0 * (float)pos) * f;
          v = (o <= 16) ? cosf(ang) : -sinf(ang);
        }
        zb[rw * 36 + o] = v;
      }
      __syncthreads();
      {
        float acc = p.in[I_HB1][l * 64 + o];
        const float* w1 = p.in[I_HW1] + (size_t)l * 33 * 64 + o;
        float wv[33];
#pragma unroll
        for (int i = 0; i < 33; ++i) wv[i] = w1[i * 64];
#pragma unroll
        for (int i = 0; i < 33; ++i) acc += zb[rw * 36 + i] * wv[i];
        h1[rw * 64 + o] = sinf(p.in[I_HFREQ][(l * 2 + 0) * 64 + o] * acc);
      }
      __syncthreads();
      {
        float acc = p.in[I_HB2][l * 64 + o];
        const float* w2 = p.in[I_HW2] + (size_t)l * 64 * 64 + o;
        float wv[64];
#pragma unroll
        for (int i = 0; i < 64; ++i) wv[i] = w2[i * 64];
#pragma unroll
        for (int i = 0; i < 64; ++i) acc += h1[rw * 64 + i] * wv[i];
        ((float*)(p.ws + OFF_HID2))[((size_t)l * 2304 + rr) * 64 + o] = sinf(p.in[I_HFREQ][(l * 2 + 1) * 64 + o] * acc);
      }
      __syncthreads();
      continue;
    }
    it -= N_HID;
    {
      int idx = it * 256 + tid; int pp = idx >> 6, i = idx & 63;
      float inv = powf(10000.f, -(float)(i & 31) / 32.f);
      float ang = (i < 32 ? (float)(pp >> 6) : (float)(pp & 63)) * inv;
      float* rp = (float*)(p.ws + OFF_ROPE);
      rp[idx] = cosf(ang); rp[2048 * 64 + idx] = sinf(ang);
    }
  } while (0);
}


DI void split8(const float* f, bf16x8& hi, bf16x8& lo) {
#pragma unroll
  for (int q = 0; q < 8; ++q) { u16 hb = f2bf(f[q]); hi[q] = (short)hb; lo[q] = (short)f2bf(f[q] - bf2f(hb)); }
}
DI void filt_item(const Params& p, int item) {
  const int tid = get_tid(), lane = tid & 63, w = tid >> 6, r = lane & 31, h = lane >> 5;
  {
    int l = item / 576, rem = item % 576, chunk = rem >> 6, cgp = rem & 63;
    int ls = chunk > 0, L = ls ? 2048 : 256, rowbase = ls ? 256 : 0, posc = ls ? (chunk - 1) * 256 : 0;
    int col = cgp * 32 + r;
    int ord = col >> 10, dir = (col >> 9) & 1, c = col & 511;
    bf16x8 bh[4], bl[4];
#pragma unroll
    for (int ks = 0; ks < 4; ++ks) {
      float f[8];
#pragma unroll
      for (int q = 0; q < 8; ++q) f[q] = p.in[I_HW3][((size_t)l * 64 + ks * 16 + 8 * h + q) * 2048 + col];
      split8(f, bh[ks], bl[ks]);
    }
    const float mind = logf(1e-2f) / 1.5f, maxd = logf(1e-2f) / 0.3f;
    float delta = fabsf(mind + (float)c * ((maxd - mind) / 511.f));
    float invLm1 = 1.f / (float)(L - 1);
    u16* dst = (u16*)(p.ws + OFF_FILT) + ((size_t)((l * 2 + ord) * 2 + dir) * 512 + c) * 2304 + rowbase;
    float asum = 0.f;
    float4 hq[2][4][2];
#pragma unroll
    for (int tt = 0; tt < 2; ++tt) {
      const float* hrow = (const float*)(p.ws + OFF_HID2) + ((size_t)l * 2304 + rowbase + posc + (w * 2 + tt) * 32 + r) * 64;
#pragma unroll
      for (int ks = 0; ks < 4; ++ks) { hq[tt][ks][0] = *(const float4*)(hrow + ks * 16 + 8 * h); hq[tt][ks][1] = *(const float4*)(hrow + ks * 16 + 8 * h + 4); }
    }
#pragma unroll
    for (int tt = 0; tt < 2; ++tt) {
      int pos0 = posc + (w * 2 + tt) * 32;
      f32x16 acc = zero16();
#pragma unroll
      for (int ks = 0; ks < 4; ++ks) {
        float4 x0 = hq[tt][ks][0], x1 = hq[tt][ks][1];
        float f[8] = {x0.x, x0.y, x0.z, x0.w, x1.x, x1.y, x1.z, x1.w};
        bf16x8 ah, al; split8(f, ah, al);
        acc = mfma32(ah, bh[ks], acc); acc = mfma32(ah, bl[ks], acc); acc = mfma32(al, bh[ks], acc);
      }
#pragma unroll
      for (int g = 0; g < 4; ++g) {
        float o[4];
#pragma unroll
        for (int q = 0; q < 4; ++q) {
          int pos = pos0 + 8 * g + 4 * h + q;
          float hv = acc[4 * g + q] * __expf(-((float)pos * invLm1) * delta);
          asum += fabsf(hv); o[q] = hv;
        }
        uint2 o2; o2.x = pack2(o[0], o[1]); o2.y = pack2(o[2], o[3]);
        *(uint2*)(dst + pos0 + 8 * g + 4 * h) = o2;
      }
    }
    asum += __shfl_xor(asum, 32);
    if (h == 0) atomicAdd((float*)(p.ws + OFF_CSUM) + (l * 2 + ls) * 2048 + col, asum);
  }
}

DI void norm_item(const Params& p, int l, bool fin, int item) {
  const int tid = get_tid(), lane = tid & 63, wv = tid >> 6;
  {
    int m = item * 4 + wv;
    const float* src = (l == 0 && !fin) ? (m < MCTX ? p.in[I_XP] + (size_t)m * D : p.in[I_XS] + (size_t)(m - MCTX) * D)
                                        : p.out + (size_t)m * D;
    float4 v[4]; float ss = 0.f;
#pragma unroll
    for (int i = 0; i < 4; ++i) { v[i] = *(const float4*)(src + (i * 64 + lane) * 4); ss += v[i].x * v[i].x + v[i].y * v[i].y + v[i].z * v[i].z + v[i].w * v[i].w; }
    for (int o = 32; o >= 1; o >>= 1) ss += __shfl_xor(ss, o);
    float rstd = rsqrtf(ss * (1.f / 1024.f) + EPSF);
    if (fin) {
      float* dst = p.out + (size_t)m * D;
      float4 gq[4];
#pragma unroll
      for (int i = 0; i < 4; ++i) gq[i] = *(const float4*)(p.in[I_FING] + (i * 64 + lane) * 4);
#pragma unroll
      for (int i = 0; i < 4; ++i) {
        int n = (i * 64 + lane) * 4; float4 g = gq[i];
        f32x4 o4 = {v[i].x * rstd * g.x, v[i].y * rstd * g.y, v[i].z * rstd * g.z, v[i].w * rstd * g.w};
        __builtin_nontemporal_store(o4, (f32x4*)(dst + n));
      }
    } else {
      int bb = m < MCTX ? 0 : 1 + ((m - MCTX) >> 11);
      const float* modp = (const float*)(p.ws + OFF_MOD) + (l * 5 + bb) * 3072;
      u16* dst = (u16*)(p.ws + OFF_HY) + (size_t)m * D;
      float4 gq[4], shq[4], scq[4];
#pragma unroll
      for (int i = 0; i < 4; ++i) { int n = (i * 64 + lane) * 4; gq[i] = *(const float4*)(p.in[I_NORMG] + l * D + n); shq[i] = *(const float4*)(modp + n); scq[i] = *(const float4*)(modp + 1024 + n); }
#pragma unroll
      for (int i = 0; i < 4; ++i) {
        int n = (i * 64 + lane) * 4;
        float4 g = gq[i];
        float4 sh = shq[i], sc = scq[i];
        float a = v[i].x * rstd * g.x * (1.f + sc.x) + sh.x, b = v[i].y * rstd * g.y * (1.f + sc.y) + sh.y;
        float c = v[i].z * rstd * g.z * (1.f + sc.z) + sh.z, d = v[i].w * rstd * g.w * (1.f + sc.w) + sh.w;
        uint2 o2; o2.x = pack2(a, b); o2.y = pack2(c, d);
        *(uint2*)(dst + n) = o2;
      }
    }
  }
}

DI void glds16(const void* g, void* l) { __builtin_amdgcn_global_load_lds((const unsigned*)g, (unsigned*)l, 16, 0, 0); }

template <int MODE, int MT>
DI void gemm_tile(const Params& p, int l, const u16* A, int lda, const u16* Bt, int ldb, int K, int brow, int bcol, char* smem) {
  const int tid = get_tid(), lane = tid & 63, wid = tid >> 6, wr = wid >> 1, wc = wid & 1, fr = lane & 15, fq = lane >> 4;
  f32x4 acc[MT][4];
#pragma unroll
  for (int m = 0; m < MT; ++m)
#pragma unroll
    for (int n = 0; n < 4; ++n) acc[m][n] = f32x4{0.f, 0.f, 0.f, 0.f};
  const int nt = K / 64;
  auto stage = [&](int kt, int b) {
    char* sa = smem + b * 32768; char* sb = sa + 16384;
#pragma unroll
    for (int i = 0; i < 4; ++i) {
      int byte = tid * 16 + i * 4096; int r = byte >> 7, cp = (byte & 127) >> 4, c = cp ^ (r & 7);
      if (i < MT) glds16(A + (size_t)(brow + r) * lda + kt * 64 + c * 8, sa + byte);
      glds16(Bt + (size_t)(bcol + r) * ldb + kt * 64 + c * 8, sb + byte);
    }
  };
  asm volatile("s_waitcnt vmcnt(0)" ::: "memory");
  stage(0, 0);
  stage(1, 1);
  for (int t = 0; t < nt; ++t) {
    if (t + 1 < nt) { if (MT == 4) asm volatile("s_waitcnt vmcnt(8)" ::: "memory"); else if (MT == 3) asm volatile("s_waitcnt vmcnt(7)" ::: "memory"); else asm volatile("s_waitcnt vmcnt(6)" ::: "memory"); }
    else asm volatile("s_waitcnt vmcnt(0)" ::: "memory");
    __builtin_amdgcn_s_barrier();
    const char* sa = smem + (t & 1) * 32768; const char* sb = sa + 16384;
    bf16x8 af[2][MT], bfr[2][4];
#pragma unroll
    for (int ks = 0; ks < 2; ++ks) {
#pragma unroll
      for (int m = 0; m < MT; ++m) { int R = wr * (16 * MT) + m * 16 + fr; af[ks][m] = *(const bf16x8*)(sa + R * 128 + (((ks * 4 + fq) ^ (R & 7)) << 4)); }
#pragma unroll
      for (int n = 0; n < 4; ++n) { int R = wc * 64 + n * 16 + fr; bfr[ks][n] = *(const bf16x8*)(sb + R * 128 + (((ks * 4 + fq) ^ (R & 7)) << 4)); }
      __builtin_amdgcn_sched_barrier(0);
    }
#pragma unroll
    for (int ks = 0; ks < 2; ++ks) {
      if (ks == 1) {
        asm volatile("s_waitcnt lgkmcnt(0)" ::: "memory");
        __builtin_amdgcn_s_barrier();
        if (t + 2 < nt) stage(t + 2, t & 1);
        __builtin_amdgcn_sched_barrier(0);
      }
      __builtin_amdgcn_s_setprio(1);
#pragma unroll
      for (int m = 0; m < MT; ++m)
#pragma unroll
        for (int n = 0; n < 4; ++n) {
          if (MODE == 1) acc[m][n] = mfma16(af[ks][m], bfr[ks][n], acc[m][n]);
          else           acc[m][n] = mfma16(bfr[ks][n], af[ks][m], acc[m][n]);
        }
      __builtin_amdgcn_s_setprio(0);
      __builtin_amdgcn_sched_barrier(0);
    }
  }
  if (MODE == 0) {
    u16* z = (u16*)(p.ws + OFF_ZRL);
    int cb = bcol < 2048 ? bcol : bcol - 2048;
#pragma unroll
    for (int m = 0; m < MT; ++m)
#pragma unroll
      for (int n = 0; n < 4; ++n) {
        int mrow = brow + wr * (16 * MT) + m * 16 + fr, ncol = cb + wc * 64 + n * 16 + fq * 4;
        uint2 o; o.x = pack2(acc[m][n][0], acc[m][n][1]); o.y = pack2(acc[m][n][2], acc[m][n][3]);
        *(uint2*)(z + (size_t)mrow * ZRL_LD + ncol) = o;
      }
  } else if (MODE == 1) {
    u16* zt = (u16*)(p.ws + OFF_ZT);
#pragma unroll
    for (int m = 0; m < MT; ++m)
#pragma unroll
      for (int n = 0; n < 4; ++n) {
        int mrow = brow + wr * (16 * MT) + m * 16 + fq * 4, ch = bcol - 2048 + wc * 64 + n * 16 + fr;
        uint2 o; o.x = pack2(acc[m][n][0], acc[m][n][1]); o.y = pack2(acc[m][n][2], acc[m][n][3]);
        *(uint2*)(zt + (size_t)ch * MTOK + mrow) = o;
      }
  } else {
    float4 xq[MT][4], gq[MT][4];
#pragma unroll
    for (int m = 0; m < MT; ++m) {
      int mrow = brow + wr * (16 * MT) + m * 16 + fr;
      int bb = mrow < MCTX ? 0 : 1 + ((mrow - MCTX) >> 11);
      const float* gate = (const float*)(p.ws + OFF_MOD) + (l * 5 + bb) * 3072 + 2048;
      const float* xs = (l == 0) ? (mrow < MCTX ? p.in[I_XP] + (size_t)mrow * D : p.in[I_XS] + (size_t)(mrow - MCTX) * D)
                                 : p.out + (size_t)mrow * D;
#pragma unroll
      for (int n = 0; n < 4; ++n) {
        int ncol = bcol + wc * 64 + n * 16 + fq * 4;
        f32x4 t4 = __builtin_nontemporal_load((const f32x4*)(xs + ncol));
        xq[m][n] = make_float4(t4[0], t4[1], t4[2], t4[3]); gq[m][n] = *(const float4*)(gate + ncol);
      }
    }
#pragma unroll
    for (int m = 0; m < MT; ++m) {
      int mrow = brow + wr * (16 * MT) + m * 16 + fr;
      float* xd = p.out + (size_t)mrow * D;
#pragma unroll
      for (int n = 0; n < 4; ++n) {
        int ncol = bcol + wc * 64 + n * 16 + fq * 4;
        float4 xv = xq[m][n], gv = gq[m][n];
        float4 o = make_float4(xv.x + gv.x * acc[m][n][0], xv.y + gv.y * acc[m][n][1], xv.z + gv.z * acc[m][n][2], xv.w + gv.w * acc[m][n][3]);
        *(float4*)(xd + ncol) = o;
      }
    }
  }
  __syncthreads();
}

template <int MODE>
DI void gemm_tile_big(const Params& p, int l, const u16* A, int lda, const u16* Bt, int ldb, int K, int brow, int bcol, char* smem) {
  const int tid = get_tid(), lane = tid & 63, w = tid >> 6, fr = lane & 15, fq = lane >> 4;
  f32x4 acc[4][8];
#pragma unroll
  for (int m = 0; m < 4; ++m)
#pragma unroll
    for (int n = 0; n < 8; ++n) acc[m][n] = f32x4{0.f, 0.f, 0.f, 0.f};
  const int nt = K / 32;
  auto stage = [&](int kt, int b) {
    char* sa = smem + b * 24576; char* sb = sa + 16384;
#pragma unroll
    for (int i = 0; i < 4; ++i) {
      int byte = tid * 16 + i * 4096; int r = byte >> 6, cp = (byte & 63) >> 4, c = cp ^ ((r >> 2) & 3);
      glds16(A + (size_t)(brow + r) * lda + kt * 32 + c * 8, sa + byte);
      if (i < 2) glds16(Bt + (size_t)(bcol + r) * ldb + kt * 32 + c * 8, sb + byte);
    }
  };
  stage(0, 0);
  for (int t = 0; t < nt; ++t) {
    asm volatile("s_waitcnt vmcnt(0)" ::: "memory");
    __syncthreads();
    if (t + 1 < nt) stage(t + 1, (t + 1) & 1);
    const char* sa = smem + (t & 1) * 24576; const char* sb = sa + 16384;
    bf16x8 af[4], bfr[8];
#pragma unroll
    for (int m = 0; m < 4; ++m) { int R = w * 64 + m * 16 + fr; af[m] = *(const bf16x8*)(sa + R * 64 + ((fq ^ ((R >> 2) & 3)) << 4)); }
#pragma unroll
    for (int n = 0; n < 8; ++n) { int R = n * 16 + fr; bfr[n] = *(const bf16x8*)(sb + R * 64 + ((fq ^ ((R >> 2) & 3)) << 4)); }
    __builtin_amdgcn_sched_barrier(0);
    __builtin_amdgcn_s_setprio(1);
#pragma unroll
    for (int m = 0; m < 4; ++m)
#pragma unroll
      for (int n = 0; n < 8; ++n) {
        if (MODE == 1) acc[m][n] = mfma16(af[m], bfr[n], acc[m][n]);
        else           acc[m][n] = mfma16(bfr[n], af[m], acc[m][n]);
      }
    __builtin_amdgcn_s_setprio(0);
    __builtin_amdgcn_sched_barrier(0);
  }
  if (MODE == 0) {
    u16* z = (u16*)(p.ws + OFF_ZRL);
    int cb = bcol < 2048 ? bcol : bcol - 2048;
#pragma unroll
    for (int m = 0; m < 4; ++m)
#pragma unroll
      for (int n = 0; n < 8; ++n) {
        int mrow = brow + w * 64 + m * 16 + fr, ncol = cb + n * 16 + fq * 4;
        uint2 o; o.x = pack2(acc[m][n][0], acc[m][n][1]); o.y = pack2(acc[m][n][2], acc[m][n][3]);
        *(uint2*)(z + (size_t)mrow * ZRL_LD + ncol) = o;
      }
  } else if (MODE == 1) {
    u16* zt = (u16*)(p.ws + OFF_ZT);
#pragma unroll
    for (int m = 0; m < 4; ++m)
#pragma unroll
      for (int n = 0; n < 8; ++n) {
        int mrow = brow + w * 64 + m * 16 + fq * 4, ch = bcol - 2048 + n * 16 + fr;
        uint2 o; o.x = pack2(acc[m][n][0], acc[m][n][1]); o.y = pack2(acc[m][n][2], acc[m][n][3]);
        *(uint2*)(zt + (size_t)ch * MTOK + mrow) = o;
      }
  } else {
#pragma unroll
    for (int m = 0; m < 4; ++m) {
      int mrow = brow + w * 64 + m * 16 + fr;
      int bb = mrow < MCTX ? 0 : 1 + ((mrow - MCTX) >> 11);
      const float* gate = (const float*)(p.ws + OFF_MOD) + (l * 5 + bb) * 3072 + 2048;
      const float* xs = (l == 0) ? (mrow < MCTX ? p.in[I_XP] + (size_t)mrow * D : p.in[I_XS] + (size_t)(mrow - MCTX) * D)
                                 : p.out + (size_t)mrow * D;
      float* xd = p.out + (size_t)mrow * D;
      float4 xq[8], gq[8];
#pragma unroll
      for (int n = 0; n < 8; ++n) { int ncol = bcol + n * 16 + fq * 4; xq[n] = *(const float4*)(xs + ncol); gq[n] = *(const float4*)(gate + ncol); }
#pragma unroll
      for (int n = 0; n < 8; ++n) {
        int ncol = bcol + n * 16 + fq * 4;
        float4 xv = xq[n], gv = gq[n];
        float4 o = make_float4(xv.x + gv.x * acc[m][n][0], xv.y + gv.y * acc[m][n][1], xv.z + gv.z * acc[m][n][2], xv.w + gv.w * acc[m][n][3]);
        *(float4*)(xd + ncol) = o;
      }
    }
  }
  __syncthreads();
}

DI void phase_gemm1(const Params& p, int l, char* smem) {
  const u16* A = (const u16*)(p.ws + OFF_HY);
  const u16* Bt = (const u16*)(p.ws + OFF_WIN) + (size_t)l * DIN * D;
  if (gridDim.x == 512) {
    const int x = blockIdx.x & 7, j = blockIdx.x >> 3;
    for (int k = 0; k < 8; ++k) {
      int st, i = j & 7, jj = j >> 3;
      if (k < 7) st = k * 8 + x;
      else { if (j >= 32) break; st = 56 + (x >> 1); jj = (j >> 3) + 4 * (x & 1); }
      int mt = (st / 5) * 8 + i, ntile = (st % 5) * 8 + jj;
      int brow = mt * 128, bcol = ntile * 128;
      if (bcol >= 2048 && bcol < 4096) gemm_tile<1, 4>(p, l, A, D, Bt, D, D, brow, bcol, smem);
      else                             gemm_tile<0, 4>(p, l, A, D, Bt, D, D, brow, bcol, smem);
    }
    if (l == 0) {
      const int fb = (j >= 32) ? (x * 32 + (j - 32)) : (256 + x * 32 + j);
      for (int it = fb; it < 1152; it += 512) filt_item(p, it);
    }
    return;
  }
  const int nitems = 96 * 40 + (l == 0 ? 1152 : 0);
  for (int t = blockIdx.x; t < nitems; t += gridDim.x) {
    if (t >= 96 * 40) { filt_item(p, t - 96 * 40); continue; }
    int mt = t / 40, ntile = t % 40;
    int brow = mt * 128, bcol = ntile * 128;
    if (bcol >= 2048 && bcol < 4096) gemm_tile<1, 4>(p, l, A, D, Bt, D, D, brow, bcol, smem);
    else                             gemm_tile<0, 4>(p, l, A, D, Bt, D, D, brow, bcol, smem);
  }
}
DI void phase_gemm2(const Params& p, int l, char* smem) {
  const u16* A = (const u16*)(p.ws + OFF_HY);
  const u16* Bt = (const u16*)(p.ws + OFF_WOUT) + (size_t)l * D * DMIX;
  if (gridDim.x == 512) {
    const int x = blockIdx.x & 7, j = blockIdx.x >> 3;
    for (int k = 0; k < 2; ++k) {
      int mt = (k * 8 + x) * 8 + (j & 7), ntile = j >> 3;
      gemm_tile<2, 3>(p, l, A, DMIX, Bt, DMIX, DMIX, mt * 96, ntile * 128, smem);
    }
    return;
  }
  for (int t = blockIdx.x; t < 128 * 8; t += gridDim.x) {
    int mt = t / 8, ntile = t % 8;
    gemm_tile<2, 3>(p, l, A, DMIX, Bt, DMIX, DMIX, mt * 96, ntile * 128, smem);
  }
}

struct RopeRaw { uint4 va, vb; float4 c0, c1, s0, s1; };
DI void rope_load(const Params& p, const u16* zrow, int d0, bool sample, int pos, RopeRaw& rr) {
  rr.va = *(const uint4*)(zrow + d0); rr.vb = *(const uint4*)(zrow + d0 + 64);
  if (sample) {
    const float* cs = (const float*)(p.ws + OFF_ROPE) + (size_t)pos * 64 + d0;
    const float* sn = cs + 2048 * 64;
    rr.c0 = *(const float4*)cs; rr.c1 = *(const float4*)(cs + 4); rr.s0 = *(const float4*)sn; rr.s1 = *(const float4*)(sn + 4);
  }
}
DI void rope_finish(const RopeRaw& rr, bool sample, float* a, float* b) {
  unpack8(rr.va, a); unpack8(rr.vb, b);
  if (sample) {
    const float c[8] = {rr.c0.x, rr.c0.y, rr.c0.z, rr.c0.w, rr.c1.x, rr.c1.y, rr.c1.z, rr.c1.w};
    const float s[8] = {rr.s0.x, rr.s0.y, rr.s0.z, rr.s0.w, rr.s1.x, rr.s1.y, rr.s1.z, rr.s1.w};
#pragma unroll
    for (int q = 0; q < 8; ++q) { float x = a[q], y = b[q]; a[q] = x * c[q] - y * s[q]; b[q] = x * s[q] + y * c[q]; }
  }
}

DI void ret_kv_item(const Params& p, int l, int item, char* smem) {
  const int tid = get_tid(), lane = tid & 63, w = tid >> 6, r = lane & 31, h = lane >> 5;
  const int hd = item & 3, s = item >> 2;
  const bool sample = s >= 32;
  const int n = sample ? ((s - 32) & 15) : (s & 1);
  const int m0 = s * 128;
  u16* vT = (u16*)smem; u16* kT = (u16*)(smem + 32768);
  const u16* zrl = (const u16*)(p.ws + OFF_ZRL);
  const float lgf = logsig(p.in[I_RLOGIT][(l * 2 + 0) * 4 + hd]), lgb = logsig(p.in[I_RLOGIT][(l * 2 + 1) * 4 + hd]);
  uint4 va[4], vb[4];
#pragma unroll
  for (int it = 0; it < 4; ++it) {
    int pidx = it * 256 + tid, jp = pidx & 63, fg = pidx >> 6;
    const u16* sp = zrl + (size_t)(m0 + 2 * jp) * ZRL_LD + 1024 + hd * 128 + fg * 8;
    va[it] = *(const uint4*)sp; vb[it] = *(const uint4*)(sp + ZRL_LD);
  }
  RopeRaw rr[4];
#pragma unroll
  for (int q4 = 0; q4 < 4; ++q4) { int hb = q4 >> 1, i2 = q4 & 1; int pidx = hb * 256 + tid, jp = pidx & 63, fg = pidx >> 6; int j = 2 * jp + i2; rope_load(p, zrl + (size_t)(m0 + j) * ZRL_LD + 512 + hd * 128, fg * 8, sample, n * 128 + j, rr[q4]); }
#pragma unroll
  for (int it = 0; it < 4; ++it) {
    int pidx = it * 256 + tid, jp = pidx & 63, fg = pidx >> 6;
#pragma unroll
    for (int q = 0; q < 8; ++q) *(unsigned*)(vT + swz(fg * 8 + q, 2 * jp)) = pair16(va[it], vb[it], q);
  }
  uint4 kpa[4], kpb[4];
#pragma unroll
  for (int q4 = 0; q4 < 4; ++q4) { float a[8], b[8]; rope_finish(rr[q4], sample, a, b); kpa[q4] = pack8(a); kpb[q4] = pack8(b); }
  _Pragma("unroll 1")
  for (int dir = 0; dir < 2; ++dir) {
    int tl = tid; asm volatile("" : "+v"(tl));
#pragma unroll
    for (int it = 0; it < 2; ++it) {
      int pidx = it * 256 + tl, jp = pidx & 63, fg = pidx >> 6, j = 2 * jp;
      float w0 = 0.08838834764831845f * (dir == 0 ? __expf((float)(127 - j) * lgf) : __expf((float)j * lgb));
      float w1 = 0.08838834764831845f * (dir == 0 ? __expf((float)(126 - j) * lgf) : __expf((float)(j + 1) * lgb));
      float a0[8], b0[8], a1[8], b1[8];
      unpack8(kpa[it * 2], a0); unpack8(kpb[it * 2], b0); unpack8(kpa[it * 2 + 1], a1); unpack8(kpb[it * 2 + 1], b1);
#pragma unroll
      for (int q = 0; q < 8; ++q) {
        *(unsigned*)(kT + swz(fg * 8 + q, j)) = pack2(a0[q] * w0, a1[q] * w1);
        *(unsigned*)(kT + swz(64 + fg * 8 + q, j)) = pack2(b0[q] * w0, b1[q] * w1);
      }
    }
    __syncthreads();
    f32x16 acc[4];
#pragma unroll
    for (int ct = 0; ct < 4; ++ct) acc[ct] = zero16();
#pragma unroll
    for (int ks = 0; ks < 8; ++ks) {
      bf16x8 a = ldfrag(kT, 32 * w + r, ks * 16 + 8 * h);
#pragma unroll
      for (int ct = 0; ct < 4; ++ct) { bf16x8 b = ldfrag(vT, 32 * ct + r, ks * 16 + 8 * h); acc[ct] = mfma32(a, b, acc[ct]); }
    }
    u16* kv = (u16*)(p.ws + OFF_KV) + (size_t)((s * 4 + hd) * 2 + dir) * 16384;
#pragma unroll
    for (int ct = 0; ct < 4; ++ct)
#pragma unroll
      for (int g = 0; g < 4; ++g) {
        int e = 32 * ct + r, d0 = 32 * w + 8 * g + 4 * h;
        uint2 o; o.x = pack2(acc[ct][4 * g], acc[ct][4 * g + 1]); o.y = pack2(acc[ct][4 * g + 2], acc[ct][4 * g + 3]);
        *(uint2*)(kv + e * 128 + d0) = o;
      }
    __syncthreads();
  }
}

DI void ret_scan_item(const Params& p, int l, int item) {
  const int tid = get_tid();
  u16* kvb = (u16*)(p.ws + OFF_KV);
  if (item < 256) {
    const int part = item & 7, dir = (item >> 3) & 1, hd = (item >> 4) & 3, b = item >> 6;
    const int pidx = part * 256 + tid, cch = pidx & 15, e = pidx >> 4, d0 = cch * 8;
    const float dec = __expf(128.f * logsig(p.in[I_RLOGIT][(l * 2 + dir) * 4 + hd]));
    float R[8];
    const float* s0 = p.in[I_SRET] + ((((size_t)(b * 2 + l) * 2 + dir) * 4 + hd) * 128 + d0) * 128 + e;
#pragma unroll
    for (int q = 0; q < 8; ++q) R[q] = s0[q * 128];
    const int slot0 = 32 + b * 16;
    uint4 kvv[16];
#pragma unroll
    for (int n = 0; n < 16; ++n) kvv[n] = *(const uint4*)(kvb + (size_t)(((slot0 + n) * 4 + hd) * 2 + dir) * 16384 + e * 128 + d0);
#pragma unroll
    for (int i = 0; i < 16; ++i) {
      const int n = dir == 0 ? i : 15 - i;
      uint4 cur = dir == 0 ? kvv[i] : kvv[15 - i];
      *(uint4*)(kvb + (size_t)(((slot0 + n) * 4 + hd) * 2 + dir) * 16384 + e * 128 + d0) = pack8(R);
      float f[8]; unpack8(cur, f);
#pragma unroll
      for (int q = 0; q < 8; ++q) R[q] = dec * R[q] + f[q];
    }
  } else {
    const int it2 = item - 256;
    const int part = it2 & 7, dir = (it2 >> 3) & 1, hd = (it2 >> 4) & 3, b = it2 >> 6;
    const int pidx = part * 256 + tid, e = pidx & 127, cch = pidx >> 7, d0 = cch * 8;
    const float dec = __expf(128.f * logsig(p.in[I_RLOGIT][(l * 2 + dir) * 4 + hd]));
    const int slot0 = b * 2;
    u16* k0 = kvb + (size_t)(((slot0 + 0) * 4 + hd) * 2 + dir) * 16384 + e * 128 + d0;
    u16* k1 = kvb + (size_t)(((slot0 + 1) * 4 + hd) * 2 + dir) * 16384 + e * 128 + d0;
    uint4 v0 = *(const uint4*)k0, v1 = *(const uint4*)k1;
    float f0[8], f1[8]; unpack8(v0, f0); unpack8(v1, f1);
    float* o = p.out + OUT_SRET + ((((size_t)(b * 2 + l) * 2 + dir) * 4 + hd) * 128 + d0) * 128 + e;
    const uint4 zz = make_uint4(0u, 0u, 0u, 0u);
    if (dir == 0) {
      *(uint4*)k0 = zz; *(uint4*)k1 = v0;
#pragma unroll
      for (int q = 0; q < 8; ++q) __builtin_nontemporal_store(dec * f0[q] + f1[q], o + q * 128);
    } else {
      *(uint4*)k1 = zz; *(uint4*)k0 = v1;
#pragma unroll
      for (int q = 0; q < 8; ++q) __builtin_nontemporal_store(dec * f1[q] + f0[q], o + q * 128);
    }
  }
}

DI void lru_scan_item(const Params& p, int l, int item) {
  const int tid = get_tid();
  const int gidx = item * 256 + tid;
  const int W = gidx & 511, dir = (gidx >> 9) & 1, seq = gidx >> 10;
  const bool ctx = seq < 16;
  const int b = ctx ? seq : seq - 16;
  const int N = ctx ? 4 : 32, slot0 = ctx ? b * 4 : 64 + b * 32;
  float* sums = (float*)(p.ws + OFF_LRUS);
  float cA[32], cB[32];
#pragma unroll
  for (int m = 0; m < 32; ++m) {
    int mc = m < N ? m : N - 1;
    cA[m] = sums[((size_t)((slot0 + mc) * 2 + dir) * 2 + 0) * 512 + W]; cB[m] = sums[((size_t)((slot0 + mc) * 2 + dir) * 2 + 1) * 512 + W];
  }
  float c = ctx ? 0.f : p.in[I_SLRU][((b * 2 + l) * 2 + dir) * 512 + W];
  if (dir == 0) {
#pragma unroll
    for (int m = 0; m < 32; ++m) if (m < N) { sums[((size_t)((slot0 + m) * 2 + dir) * 2 + 0) * 512 + W] = c; c = cA[m] * c + cB[m]; }
  } else {
#pragma unroll
    for (int m = 31; m >= 0; --m) if (m < N) { sums[((size_t)((slot0 + m) * 2 + dir) * 2 + 0) * 512 + W] = c; c = cA[m] * c + cB[m]; }
  }
}

DI void ret_out_item(const Params& p, int l, int item, char* smem) {
  const int tid = get_tid(), lane = tid & 63, w = tid >> 6, r = lane & 31, h = lane >> 5;
  const int half = item & 1, hd = (item >> 1) & 3, s = item >> 3;
  const bool sample = s >= 32;
  const int n = sample ? ((s - 32) & 15) : (s & 1);
  const int m0 = s * 128;
  u16* bufQ = (u16*)smem; u16* bufK = (u16*)(smem + 16384); u16* bufP = (u16*)(smem + 49152);
  const u16* zrl = (const u16*)(p.ws + OFF_ZRL);
  const u16* kvbase = (const u16*)(p.ws + OFF_KV);
  const float lgf = logsig(p.in[I_RLOGIT][(l * 2 + 0) * 4 + hd]), lgb = logsig(p.in[I_RLOGIT][(l * 2 + 1) * 4 + hd]);
  {
    RopeRaw rq[2], rk[4];
#pragma unroll
    for (int it = 0; it < 2; ++it) { int pidx = it * 256 + tid, fg = pidx & 7, j = pidx >> 3; rope_load(p, zrl + (size_t)(m0 + 64 * half + j) * ZRL_LD + hd * 128, fg * 8, sample, n * 128 + 64 * half + j, rq[it]); }
#pragma unroll
    for (int it = 0; it < 4; ++it) { int pidx = it * 256 + tid, fg = pidx & 7, j = pidx >> 3; rope_load(p, zrl + (size_t)(m0 + j) * ZRL_LD + 512 + hd * 128, fg * 8, sample, n * 128 + j, rk[it]); }
#pragma unroll
    for (int it = 0; it < 2; ++it) {
      int pidx = it * 256 + tid, fg = pidx & 7, j = pidx >> 3;
      float a[8], bb[8]; rope_finish(rq[it], sample, a, bb);
      *(uint4*)(bufQ + swz(j, fg * 8)) = pack8(a); *(uint4*)(bufQ + swz(j, 64 + fg * 8)) = pack8(bb);
    }
#pragma unroll
    for (int it = 0; it < 4; ++it) {
      int pidx = it * 256 + tid, fg = pidx & 7, j = pidx >> 3;
      float a[8], bb[8]; rope_finish(rk[it], sample, a, bb);
#pragma unroll
      for (int q = 0; q < 8; ++q) { a[q] *= 0.08838834764831845f; bb[q] *= 0.08838834764831845f; }
      *(uint4*)(bufK + swz(j, fg * 8)) = pack8(a); *(uint4*)(bufK + swz(j, 64 + fg * 8)) = pack8(bb);
    }
  }
  uint4 vva[4], vvb[4];
#pragma unroll
  for (int it = 0; it < 4; ++it) {
    int pidx = it * 256 + tid, jp = pidx & 63, fg = pidx >> 6;
    const u16* sp = zrl + (size_t)(m0 + 2 * jp) * ZRL_LD + 1024 + hd * 128 + fg * 8;
    vva[it] = *(const uint4*)sp; vvb[it] = *(const uint4*)(sp + ZRL_LD);
  }
  __syncthreads();
  const int rt = w & 1, cp = w >> 1;
  {
    f32x16 sacc[2]; sacc[0] = zero16(); sacc[1] = zero16();
#pragma unroll
    for (int ks = 0; ks < 8; ++ks) {
      bf16x8 a = ldfrag(bufQ, 32 * rt + r, ks * 16 + 8 * h);
#pragma unroll
      for (int c2 = 0; c2 < 2; ++c2) { bf16x8 bb = ldfrag(bufK, 32 * (2 * cp + c2) + r, ks * 16 + 8 * h); sacc[c2] = mfma32(a, bb, sacc[c2]); }
    }
#pragma unroll
    for (int c2 = 0; c2 < 2; ++c2)
#pragma unroll
      for (int i = 0; i < 16; ++i) {
        int row = 32 * rt + crow(i, h), ig = 64 * half + row, j = 32 * (2 * cp + c2) + r, diff = ig - j;
        float arg = diff > 0 ? (float)diff * lgf : (float)(-diff) * lgb;
        float wgt = __expf(arg); wgt = diff == 0 ? 2.f : wgt;
        bufP[swz(row, j)] = f2bf(sacc[c2][i] * wgt);
      }
  }
  __syncthreads();
#pragma unroll
  for (int it = 0; it < 4; ++it) {
    int pidx = it * 256 + tid, jp = pidx & 63, fg = pidx >> 6;
#pragma unroll
    for (int q = 0; q < 8; ++q) *(unsigned*)(bufK + swz(fg * 8 + q, 2 * jp)) = pair16(vva[it], vvb[it], q);
  }
  u32x32 rv;
#pragma unroll
  for (int it = 0; it < 8; ++it) { int pidx = it * 256 + tid; u32x4 t4 = *(const u32x4*)(kvbase + (size_t)((s * 4 + hd) * 2 + 0) * 16384 + pidx * 8); rv[4 * it] = t4[0]; rv[4 * it + 1] = t4[1]; rv[4 * it + 2] = t4[2]; rv[4 * it + 3] = t4[3]; }
  __syncthreads();
  f32x16 oacc[2]; oacc[0] = zero16(); oacc[1] = zero16();
#pragma unroll
  for (int ks = 0; ks < 8; ++ks) {
    bf16x8 a = ldfrag(bufP, 32 * rt + r, ks * 16 + 8 * h);
#pragma unroll
    for (int c2 = 0; c2 < 2; ++c2) { bf16x8 bb = ldfrag(bufK, 32 * (2 * cp + c2) + r, ks * 16 + 8 * h); oacc[c2] = mfma32(a, bb, oacc[c2]); }
  }
  __syncthreads();
  u32x32 rv1;
#define RET_CROSS(DIR, RCUR)                                                                                                   \
  {                                                                                                                            \
    const float lg = (DIR) == 0 ? lgf : lgb;                                                                                   \
    _Pragma("unroll") for (int it = 0; it < 8; ++it) { int pidx = it * 256 + tid, cch = pidx & 15, e = pidx >> 4; u32x4 t4 = {RCUR[4 * it], RCUR[4 * it + 1], RCUR[4 * it + 2], RCUR[4 * it + 3]}; *(u32x4*)(bufK + swz(e, cch * 8)) = t4; } \
    if ((DIR) == 0) {                                                                                                          \
      _Pragma("unroll") for (int it = 0; it < 8; ++it) { int pidx = it * 256 + tid; u32x4 t4 = *(const u32x4*)(kvbase + (size_t)((s * 4 + hd) * 2 + 1) * 16384 + pidx * 8); rv1[4 * it] = t4[0]; rv1[4 * it + 1] = t4[1]; rv1[4 * it + 2] = t4[2]; rv1[4 * it + 3] = t4[3]; } \
    }                                                                                                                          \
    __syncthreads();                                                                                                           \
    f32x16 cacc[2]; cacc[0] = zero16(); cacc[1] = zero16();                                                                    \
    _Pragma("unroll") for (int ks = 0; ks < 8; ++ks) {                                                                         \
      bf16x8 a = ldfrag(bufQ, 32 * rt + r, ks * 16 + 8 * h);                                                                   \
      _Pragma("unroll") for (int c2 = 0; c2 < 2; ++c2) { bf16x8 bb = ldfrag(bufK, 32 * (2 * cp + c2) + r, ks * 16 + 8 * h); cacc[c2] = mfma32(a, bb, cacc[c2]); } \
    }                                                                                                                          \
    _Pragma("unroll") for (int i = 0; i < 16; ++i) {                                                                           \
      int ig = 64 * half + 32 * rt + crow(i, h);                                                                               \
      float xw = (DIR) == 0 ? __expf((float)(ig + 1) * lg) : __expf((float)(128 - ig) * lg);                                   \
      oacc[0][i] += xw * cacc[0][i]; oacc[1][i] += xw * cacc[1][i];                                                            \
    }                                                                                                                          \
    __syncthreads();                                                                                                           \
  }
  RET_CROSS(0, rv)
  RET_CROSS(1, rv1)
#undef RET_CROSS
  float* red = (float*)(smem + 65536 - 512);
  float* O32 = (float*)(smem + 16384);
  float ss[16];
#pragma unroll
  for (int i = 0; i < 16; ++i) {
    float v = oacc[0][i] * oacc[0][i] + oacc[1][i] * oacc[1][i];
    v += __shfl_xor(v, 1); v += __shfl_xor(v, 2); v += __shfl_xor(v, 4); v += __shfl_xor(v, 8); v += __shfl_xor(v, 16);
    ss[i] = v;
  }
  if (r == 0) {
#pragma unroll
    for (int i = 0; i < 16; ++i) red[cp * 64 + 32 * rt + crow(i, h)] = ss[i];
  }
#pragma unroll
  for (int i = 0; i < 16; ++i) {
    int row = 32 * rt + crow(i, h);
    O32[row * 132 + 32 * (2 * cp) + r] = oacc[0][i]; O32[row * 132 + 32 * (2 * cp + 1) + r] = oacc[1][i];
  }
  uint4 gv[4];
#pragma unroll
  for (int k = 0; k < 4; ++k) { int idx = tid + 256 * k, row = idx >> 4, c16 = idx & 15; gv[k] = *(const uint4*)(zrl + (size_t)(m0 + 64 * half + row) * ZRL_LD + 1536 + hd * 128 + c16 * 8); }
  __syncthreads();
  u16* y = (u16*)(p.ws + OFF_HY);
#pragma unroll
  for (int k = 0; k < 4; ++k) {
    int idx = tid + 256 * k, row = idx >> 4, c16 = idx & 15;
    float rstd = rsqrtf((red[row] + red[64 + row]) * (1.f / 128.f) + EPSF);
    float4 x0 = *(const float4*)(O32 + row * 132 + c16 * 8), x1 = *(const float4*)(O32 + row * 132 + c16 * 8 + 4);
    float g[8]; unpack8(gv[k], g);
    float o[8] = {x0.x, x0.y, x0.z, x0.w, x1.x, x1.y, x1.z, x1.w};
#pragma unroll
    for (int q = 0; q < 8; ++q) o[q] = o[q] * rstd * siluf(g[q]);
    *(uint4*)(y + (size_t)(m0 + 64 * half + row) * DMIX + hd * 128 + c16 * 8) = pack8(o);
  }
  __syncthreads();
}

DI void lru_items(const Params& p, int l, int mode, int first, int last, char* smem) {
  const int tid = get_tid(), lane = tid & 63, w = tid >> 6, r = lane & 31, h = lane >> 5;
  if (first >= last) return;
  const int blk = first & 7;
  u16* ubf = (u16*)smem;
  float* X = (float*)(smem + 8192);
  float* Y = X + 64 * 65;
  float* Z = Y + 64 * 65;
  float* seg = Z + 64 * 65;
  const u16* zrl = (const u16*)(p.ws + OFF_ZRL);
  const int c8 = tid & 7, W0 = blk * 64 + c8 * 8;
  float* cwl = seg + 512;
  for (int idx = tid; idx < 320; idx += 256) cwl[idx] = idx < 256 ? p.in[I_LCW][(l * 4 + (idx >> 6)) * 512 + blk * 64 + (idx & 63)] : p.in[I_LCB][l * 512 + blk * 64 + (idx - 256)];
  __syncthreads();
#define LRU_LOADZ(ITEM)                                                                                                        \
  {                                                                                                                            \
    const int s_ = (ITEM) >> 3; const bool ctx_ = s_ < 64; const int n_ = ctx_ ? (s_ & 3) : ((s_ - 64) & 31);                    \
    const int L_ = ctx_ ? 256 : 2048, t0_ = n_ * 64, mseq_ = s_ * 64 - t0_;                                                     \
    _Pragma("unroll") for (int it = 0; it < 2; ++it)                                                                           \
      _Pragma("unroll") for (int j = 0; j < 4; ++j) {                                                                          \
        int t = (it * 256 + tid) >> 3; int pos = t0_ + t + j - 2; int pc = pos < 0 ? 0 : (pos >= L_ ? L_ - 1 : pos);            \
        u32x4 t4 = *(const u32x4*)(zrl + (size_t)(mseq_ + pc) * ZRL_LD + 2048 + W0);                                           \
        zv[(it * 4 + j) * 4] = t4[0]; zv[(it * 4 + j) * 4 + 1] = t4[1]; zv[(it * 4 + j) * 4 + 2] = t4[2]; zv[(it * 4 + j) * 4 + 3] = t4[3]; \
      }                                                                                                                        \
  }
  u32x32 zv;
  LRU_LOADZ(first)
  const int mt = w & 1, ntl = w >> 1;
  const int ch = 32 * ntl + r, Wc = blk * 64 + ch;
  const int sch = tid & 63, sg = tid >> 6, Ws = blk * 64 + sch;
  float* sums = (float*)(p.ws + OFF_LRUS);
  bf16x8 gfr[2][2][4]; float gbv[2][2], lamv[2];
#pragma unroll
  for (int dd = 0; dd < 2; ++dd) {
    const u16* gw0 = (const u16*)(p.ws + OFF_GWT) + (size_t)((((l * 2 + dd) * 2 + 0) * 8 + blk)) * 4096 + ch * 64 + 8 * h;
#pragma unroll
    for (int ks = 0; ks < 4; ++ks) { gfr[dd][0][ks] = *(const bf16x8*)(gw0 + ks * 16); gfr[dd][1][ks] = *(const bf16x8*)(gw0 + 8 * 4096 + ks * 16); }
    gbv[dd][0] = p.in[I_LGB][((l * 2 + dd) * 2 + 0) * 512 + Wc]; gbv[dd][1] = p.in[I_LGB][((l * 2 + dd) * 2 + 1) * 512 + Wc];
    lamv[dd] = log1pf(__expf(-p.in[I_LLAM][(l * 2 + dd) * 512 + Wc]));
  }
  _Pragma("unroll 1")
  for (int item = first; item < last; item += gridDim.x) {
  const int s = item >> 3;
  const bool ctx = s < 64;
  const int b = ctx ? (s >> 2) : ((s - 64) >> 5);
  const int n = ctx ? (s & 3) : ((s - 64) & 31);
  const int N = ctx ? 4 : 32, L = ctx ? 256 : 2048;
  const int m0 = s * 64, t0 = n * 64;
  {
#pragma unroll
    for (int it = 0; it < 2; ++it) {
      int t = (it * 256 + tid) >> 3;
      float acc[8];
#pragma unroll
      for (int q = 0; q < 8; ++q) acc[q] = cwl[256 + c8 * 8 + q];
#pragma unroll
      for (int j = 0; j < 4; ++j) {
        int pos = t0 + t + j - 2;
        const unsigned mk = (pos >= 0 && pos < L) ? 0xffffffffu : 0u;
        uint4 zq = make_uint4(zv[(it * 4 + j) * 4] & mk, zv[(it * 4 + j) * 4 + 1] & mk, zv[(it * 4 + j) * 4 + 2] & mk, zv[(it * 4 + j) * 4 + 3] & mk);
        float f[8]; unpack8(zq, f);
#pragma unroll
        for (int q = 0; q < 8; ++q) acc[q] += cwl[j * 64 + c8 * 8 + q] * f[q];
      }
      *(uint4*)(ubf + swz64(t, c8 * 8)) = pack8(acc);
    }
  }
  if (item + (int)gridDim.x < last) LRU_LOADZ(item + (int)gridDim.x)
  __syncthreads();
#define LRU_DIR(DIR, Bb)                                                                                                       \
  {                                                                                                                            \
    const float gc0 = -1.4426950408889634f * gbv[DIR][0], gc1 = -1.4426950408889634f * gbv[DIR][1];                            \
    const float sp8l = -8.f * 1.4426950408889634f * lamv[DIR], sp16 = -16.f * lamv[DIR];                                       \
    float hc0 = 0.f;                                                                                                           \
    if (mode == 1) hc0 = sums[((size_t)(s * 2 + (DIR)) * 2 + 0) * 512 + Ws];                                                   \
    f32x16 g0 = zero16(), g1 = zero16();                                                                                       \
    _Pragma("unroll") for (int ks = 0; ks < 4; ++ks) {                                                                         \
      bf16x8 a = *(const bf16x8*)(ubf + swz64(32 * mt + r, ks * 16 + 8 * h));                                                  \
      g0 = mfma32(a, gfr[DIR][0][ks], g0); g1 = mfma32(a, gfr[DIR][1][ks], g1);                                                \
    }                                                                                                                          \
    u16 uraw[16];                                                                                                              \
    _Pragma("unroll") for (int i = 0; i < 16; ++i) uraw[i] = ubf[swz64(32 * mt + crow(i, h), ch)];                             \
    _Pragma("unroll") for (int i = 0; i < 16; ++i) {                                                                           \
      int t = 32 * mt + crow(i, h);                                                                                            \
      float rr = __builtin_amdgcn_rcpf(1.f + __builtin_amdgcn_exp2f(fmaf(g0[i], -1.4426950408889634f, gc0)));                  \
      float ii = __builtin_amdgcn_rcpf(1.f + __builtin_amdgcn_exp2f(fmaf(g1[i], -1.4426950408889634f, gc1)));                  \
      float av = __builtin_amdgcn_exp2f(rr * sp8l);                                                                            \
      float x2 = rr * sp16;                                                                                                    \
      float e2 = -x2 * (1.f + x2 * (0.5f + x2 * (0.16666667f + x2 * 0.041666668f)));                                           \
      float e1 = fmaf(-av, av, 1.f);                                                                                           \
      float em = x2 > -0.25f ? e2 : e1;                                                                                        \
      float uv = bf2f(uraw[i]);                                                                                                \
      X[t * 65 + ch] = av; Bb[t * 65 + ch] = __builtin_amdgcn_sqrtf(em) * (ii * uv);                                           \
    }                                                                                                                          \
    __syncthreads();                                                                                                           \
    {                                                                                                                          \
      float A = 1.f, Bv = 0.f;                                                                                                 \
      if ((DIR) == 0) { _Pragma("unroll") for (int t = 0; t < 16; ++t) { int tt = sg * 16 + t; float a = X[tt * 65 + sch]; Bv = a * Bv + Bb[tt * 65 + sch]; A *= a; } } \
      else            { _Pragma("unroll") for (int t = 15; t >= 0; --t) { int tt = sg * 16 + t; float a = X[tt * 65 + sch]; Bv = a * Bv + Bb[tt * 65 + sch]; A *= a; } } \
      seg[(0 * 4 + sg) * 64 + sch] = A; seg[(1 * 4 + sg) * 64 + sch] = Bv;                                                     \
    }                                                                                                                          \
    __syncthreads();                                                                                                           \
    if (mode == 0) {                                                                                                           \
      if (sg == 0) {                                                                                                           \
        float A = 1.f, Bv = 0.f;                                                                                               \
        if ((DIR) == 0) { for (int q = 0; q < 4; ++q) { float a = seg[q * 64 + sch]; Bv = a * Bv + seg[(4 + q) * 64 + sch]; A *= a; } } \
        else            { for (int q = 3; q >= 0; --q) { float a = seg[q * 64 + sch]; Bv = a * Bv + seg[(4 + q) * 64 + sch]; A *= a; } } \
        sums[((size_t)(s * 2 + (DIR)) * 2 + 0) * 512 + Ws] = A; sums[((size_t)(s * 2 + (DIR)) * 2 + 1) * 512 + Ws] = Bv;        \
      }                                                                                                                        \
    } else {                                                                                                                   \
      float hc = hc0;                                                                                                          \
      if ((DIR) == 0) {                                                                                                        \
        for (int q = 0; q < sg; ++q) hc = seg[q * 64 + sch] * hc + seg[(4 + q) * 64 + sch];                                    \
        _Pragma("unroll") for (int t = 0; t < 16; ++t) { int tt = sg * 16 + t; hc = X[tt * 65 + sch] * hc + Bb[tt * 65 + sch]; Bb[tt * 65 + sch] = hc; } \
        if (ctx && n == N - 1 && sg == 3) p.out[OUT_SLRU + ((size_t)(b * 2 + l) * 2 + 0) * 512 + Ws] = hc;                     \
      } else {                                                                                                                 \
        for (int q = 3; q > sg; --q) hc = seg[q * 64 + sch] * hc + seg[(4 + q) * 64 + sch];                                    \
        _Pragma("unroll") for (int t = 15; t >= 0; --t) { int tt = sg * 16 + t; hc = X[tt * 65 + sch] * hc + Bb[tt * 65 + sch]; Bb[tt * 65 + sch] = hc; } \
        if (ctx && n == 0 && sg == 0) p.out[OUT_SLRU + ((size_t)(b * 2 + l) * 2 + 1) * 512 + Ws] = hc;                          \
      }                                                                                                                        \
    }                                                                                                                          \
    __syncthreads();                                                                                                           \
  }
  LRU_DIR(0, Y)
  LRU_DIR(1, Z)
#undef LRU_DIR
  if (mode == 1) {
    u16* y = (u16*)(p.ws + OFF_HY);
    uint4 gv[2];
#pragma unroll
    for (int it = 0; it < 2; ++it) { int pidx = it * 256 + tid, c8 = pidx & 7, t = pidx >> 3; gv[it] = *(const uint4*)(zrl + (size_t)(m0 + t) * ZRL_LD + 2048 + 512 + blk * 64 + c8 * 8); }
#pragma unroll
    for (int it = 0; it < 2; ++it) {
      int pidx = it * 256 + tid, c8 = pidx & 7, t = pidx >> 3;
      float g[8], o[8]; unpack8(gv[it], g);
#pragma unroll
      for (int q = 0; q < 8; ++q) o[q] = (Y[t * 65 + c8 * 8 + q] + Z[t * 65 + c8 * 8 + q]) * siluf(g[q]);
      *(uint4*)(y + (size_t)(m0 + t) * DMIX + 1024 + blk * 64 + c8 * 8) = pack8(o);
    }
    __syncthreads();
  }
  }
#undef LRU_LOADZ
}

template <int L, int B>
DI void hyena_item(const Params& p, int l, int c, char* smem) {
  constexpr int NB = L / 32, IPG = 32 / B, NG = NB / IPG, GPW = NG / 4, PADB = IPG - 1;
  constexpr int UROW = (B == 4) ? 2568 : 392;
  constexpr int MBASE = (B == 4) ? MCTX : 0;
  constexpr int ROWB = (B == 4) ? 256 : 0;
  const int tid = get_tid(), lane = tid & 63, w = __builtin_amdgcn_readfirstlane(tid >> 6), r = lane & 31, h = lane >> 5;
  u16* TR0 = (u16*)smem;
  u16* TR1 = TR0 + 2 * L + 32;
  u16* U = TR1 + 2 * L + 32;
  u16* X1 = U + B * UROW;
  const u16* zt = (const u16*)(p.ws + OFF_ZT);
  constexpr int NIT = B * L / 8 / 256;
  constexpr int NK = L / 256;
  uint4 sv0[NIT], sv1[NIT]; u16 sl0[NIT], sr0[NIT], sl1[NIT], sr1[NIT];
  u16 fvf[2][NK], fvb[2][NK]; float fhf0[2], fbias[2], fsf[2], fsb[2];
#define STG_LOAD(CHAN, V, LF, RT)                                                                     \
  {                                                                                                   \
    const u16* src_ = zt + (size_t)(CHAN) * MTOK + MBASE;                                             \
    _Pragma("unroll") for (int k = 0; k < NIT; ++k) {                                                 \
      int idx = tid + 256 * k; int bb = idx / (L / 8), t8 = (idx % (L / 8)) * 8;                      \
      const u16* sp = src_ + bb * L + t8;                                                             \
      { u32x4 t4 = __builtin_nontemporal_load((const u32x4*)sp); V[k] = make_uint4(t4[0], t4[1], t4[2], t4[3]); } LF[k] = sp[t8 > 0 ? -1 : 0]; RT[k] = sp[(t8 + 8 < L) ? 8 : 7]; \
    }                                                                                                 \
  }
#define STG_WRITE(CHAN, V, LF, RT, DST, RSTRIDE, ROFF)                                                \
  {                                                                                                   \
    const float w0 = p.in[I_HCW][(l * 3 + 0) * 1536 + (CHAN)], w1 = p.in[I_HCW][(l * 3 + 1) * 1536 + (CHAN)], w2 = p.in[I_HCW][(l * 3 + 2) * 1536 + (CHAN)]; \
    const float bs = p.in[I_HCB][l * 1536 + (CHAN)];                                                  \
    _Pragma("unroll") for (int k = 0; k < NIT; ++k) {                                                 \
      int idx = tid + 256 * k; int bb = idx / (L / 8), t8 = (idx % (L / 8)) * 8;                      \
      float f[10]; unpack8(V[k], f + 1);                                                              \
      f[0] = t8 > 0 ? bf2f(LF[k]) : 0.f; f[9] = (t8 + 8 < L) ? bf2f(RT[k]) : 0.f;                     \
      float o[8];                                                                                     \
      _Pragma("unroll") for (int q = 0; q < 8; ++q) o[q] = w0 * f[q] + w1 * f[q + 1] + w2 * f[q + 2] + bs; \
      *(uint4*)((DST) + bb * (RSTRIDE) + (ROFF) + t8) = pack8(o);                                     \
    }                                                                                                 \
  }
  STG_LOAD(c, sv0, sl0, sr0)
  STG_LOAD(512 + c, sv1, sl1, sr1)
#pragma unroll
  for (int oo = 0; oo < 2; ++oo) {
    const u16* hf = (const u16*)(p.ws + OFF_FILT) + ((size_t)((l * 2 + oo) * 2 + 0) * 512 + c) * 2304 + ROWB;
    const u16* hb = hf + (size_t)512 * 2304;
    const float* cs = (const float*)(p.ws + OFF_CSUM) + (l * 2 + (B == 4 ? 1 : 0)) * 2048 + oo * 1024 + c;
#pragma unroll
    for (int k = 0; k < NK; ++k) { int mx = L - tid - 256 * k; fvf[oo][k] = hf[mx < L ? mx : 0]; fvb[oo][k] = hb[tid + 256 * k]; }
    fhf0[oo] = bf2f(hf[0]); fbias[oo] = p.in[I_HBIAS][(l * 2 + oo) * 512 + c];
    fsf[oo] = cs[0]; fsb[oo] = cs[512];
  }
  STG_WRITE(c, sv0, sl0, sr0, U, UROW, PADB * 32)
  STG_WRITE(512 + c, sv1, sl1, sr1, X1, L, 0)
#undef STG_LOAD
#undef STG_WRITE
  if (PADB > 0) {
    for (int idx = tid; idx < B * PADB * 32 * 2; idx += 256) {
      int bb = idx / (PADB * 64), q = idx % (PADB * 64);
      int off = q < PADB * 32 ? q : (PADB * 32 + L + (q - PADB * 32));
      U[bb * UROW + off] = 0;
    }
  }
  f32x16 acc[GPW];
  const u16* tbase = (r & 1) ? (TR1 - 1) : TR0;
  uint2 xva[GPW][4], gva[GPW][4]; u16 lfa[GPW][4], rta[GPW][4];
  _Pragma("unroll")
  for (int ord = 0; ord < 2; ++ord) {
    {
      const float sf = 1.f / (fsf[ord] + EPSF), sb = 1.f / (fsb[ord] + EPSF);
      const float hf0 = fhf0[ord], bias = fbias[ord];
#pragma unroll
      for (int k = 0; k < NK; ++k) {
        int idx = tid + 256 * k;
        u16 v = (idx == 0) ? (u16)0 : f2bf(bf2f(fvf[ord][k]) * sf);
        TR0[idx] = v; if (idx > 0) TR1[idx - 1] = v;
        int idx2 = L + tid + 256 * k;
        u16 v2 = (idx2 == L) ? f2bf(hf0 * sf + bf2f(fvb[ord][k]) * sb + bias) : f2bf(bf2f(fvb[ord][k]) * sb);
        TR0[idx2] = v2; TR1[idx2 - 1] = v2;
        if (idx2 == 2 * L - 1) TR1[idx2] = 0;
      }
    }
    __syncthreads();
#pragma unroll
    for (int gi = 0; gi < GPW; ++gi) acc[gi] = zero16();
    const int g0 = w * GPW;
    const int dmin = IPG * g0 - (NB - 1), dmax = IPG * (g0 + GPW - 1) + IPG - 1;
    const int nb_ = r % B, il = r / B;
    auto lda = [&](int d, uint4& a0, uint4& a1) {
      const unsigned* ap = (const unsigned*)(tbase + (L + 8 * h - r - 32 * d));
      a0 = make_uint4(ap[0], ap[1], ap[2], ap[3]);
      a1 = make_uint4(ap[8], ap[9], ap[10], ap[11]);
    };
    const u16* ub = U + nb_ * UROW + (PADB + IPG * g0 + il) * 32 + 8 * h;
    struct Fr { uint4 a0, a1; bf16x8 b00, b01, b10, b11; };
    auto ldall = [&](int d, Fr& f) {
      lda(d, f.a0, f.a1);
      const u16* up = ub - 32 * d;
      f.b00 = *(const bf16x8*)(up); f.b01 = *(const bf16x8*)(up + 16);
      if (GPW > 1) { f.b10 = *(const bf16x8*)(up + IPG * 32); f.b11 = *(const bf16x8*)(up + IPG * 32 + 16); }
    };
    if (ord == 1) {
      const u16* gsrc_ = zt + (size_t)(1536 + c) * MTOK + MBASE + nb_ * L;
      const u16* xsrc_ = zt + (size_t)(1024 + c) * MTOK + MBASE + nb_ * L;
      const int tbp = 32 * (IPG * g0 + il) + 4 * h;
#pragma unroll
      for (int gi = 0; gi < GPW; ++gi)
#pragma unroll
        for (int g4 = 0; g4 < 4; ++g4) {
          int tq = tbp + 32 * IPG * gi + 8 * g4;
          xva[gi][g4] = *(const uint2*)(xsrc_ + tq); gva[gi][g4] = *(const uint2*)(gsrc_ + tq);
          lfa[gi][g4] = xsrc_[tq > 0 ? tq - 1 : 0]; rta[gi][g4] = xsrc_[(tq + 4 < L) ? tq + 4 : tq];
        }
    }
    Fr X, Y;
    ldall(dmin, X);
    auto step = [&](int d, const Fr& cur, Fr& nxt, auto act0, auto act1) {
      ldall(d < dmax ? d + 1 : dmax, nxt);
      __builtin_amdgcn_sched_barrier(0);
      bf16x8 a0 = __builtin_bit_cast(bf16x8, cur.a0), a1 = __builtin_bit_cast(bf16x8, cur.a1);
      if (act0.value) { acc[0] = mfma32(a0, cur.b00, acc[0]); acc[0] = mfma32(a1, cur.b01, acc[0]); }
      if (GPW > 1 && act1.value) { acc[GPW - 1] = mfma32(a0, cur.b10, acc[GPW - 1]); acc[GPW - 1] = mfma32(a1, cur.b11, acc[GPW - 1]); }
      __builtin_amdgcn_sched_barrier(0);
    };
    auto segment = [&](int lo, int hi, auto act0, auto act1) {
      int d = lo;
      _Pragma("unroll 1") for (; d + 1 <= hi; d += 2) { step(d, X, Y, act0, act1); step(d + 1, Y, X, act0, act1); }
      if (d <= hi) { step(d, X, Y, act0, act1); X = Y; }
    };
    using T1 = std::integral_constant<bool, true>; using T0 = std::integral_constant<bool, false>;
    if (GPW > 1) {
      const int lo1 = IPG * (g0 + 1) - (NB - 1), hi0 = IPG * g0 + IPG - 1;
      segment(dmin, lo1 - 1, T1{}, T0{});
      segment(lo1, hi0, T1{}, T1{});
      segment(hi0 + 1, dmax, T0{}, T1{});
    } else {
      segment(dmin, dmax, T1{}, T0{});
    }
    __syncthreads();
    int tb = 32 * (IPG * g0 + il) + 4 * h;
    asm volatile("" : "+v"(tb));
    if (ord == 0) {
#pragma unroll
      for (int gi = 0; gi < GPW; ++gi)
#pragma unroll
        for (int i = 0; i < 16; ++i) {
          int t = tb + 32 * IPG * gi + (i & 3) + 8 * (i >> 2);
          U[nb_ * UROW + PADB * 32 + t] = f2bf(bf2f(X1[nb_ * L + t]) * acc[gi][i]);
          if ((i & 3) == 3) asm volatile("" ::: "memory");
        }
    } else {
      u16* y = (u16*)(p.ws + OFF_YT);
      const u16* gsrc = zt + (size_t)(1536 + c) * MTOK + MBASE + nb_ * L;
      const u16* xsrc = zt + (size_t)(1024 + c) * MTOK + MBASE + nb_ * L;
      const int chan = 1024 + c;
      const float w0 = p.in[I_HCW][(l * 3 + 0) * 1536 + chan], w1 = p.in[I_HCW][(l * 3 + 1) * 1536 + chan], w2 = p.in[I_HCW][(l * 3 + 2) * 1536 + chan];
      const float bs = p.in[I_HCB][l * 1536 + chan];
#pragma unroll
      for (int gi = 0; gi < GPW; ++gi)
#pragma unroll
        for (int g4 = 0; g4 < 4; ++g4) {
          int tq = tb + 32 * IPG * gi + 8 * g4;
          uint2 xv = xva[gi][g4], gv = gva[gi][g4];
          float f[6];
          f[0] = tq > 0 ? bf2f(lfa[gi][g4]) : 0.f; f[5] = (tq + 4 < L) ? bf2f(rta[gi][g4]) : 0.f;
          f[1] = __uint_as_float(xv.x << 16); f[2] = __uint_as_float(xv.x & 0xffff0000u);
          f[3] = __uint_as_float(xv.y << 16); f[4] = __uint_as_float(xv.y & 0xffff0000u);
          float gg[4] = {__uint_as_float(gv.x << 16), __uint_as_float(gv.x & 0xffff0000u), __uint_as_float(gv.y << 16), __uint_as_float(gv.y & 0xffff0000u)};
          float o[4];
#pragma unroll
          for (int q = 0; q < 4; ++q) {
            float x2 = bf2f(f2bf(w0 * f[q] + w1 * f[q + 1] + w2 * f[q + 2] + bs));
            o[q] = x2 * acc[gi][4 * g4 + q] * siluf(gg[q]);
          }
          uint2 o2; o2.x = pack2(o[0], o[1]); o2.y = pack2(o[2], o[3]);
          *(uint2*)(y + (size_t)c * MTOK + MBASE + nb_ * L + tq) = o2;
        }
    }
  }
  __syncthreads();
}

DI void ytrans_item(const Params& p, int item, char* smem) {
  const int tid = get_tid();
  u16* tile = (u16*)smem;
  const int ct = item & 7, mt = item >> 3;
  const u16* src = (const u16*)(p.ws + OFF_YT) + (size_t)(ct * 64) * MTOK + mt * 64;
  u16* y = (u16*)(p.ws + OFF_HY) + (size_t)(mt * 64) * DMIX + 512 + ct * 64;
  uint4 v[2];
#pragma unroll
  for (int k = 0; k < 2; ++k) { int idx = tid + 256 * k; int cr = idx >> 3, ch8 = idx & 7; u32x4 t4 = __builtin_nontemporal_load((const u32x4*)(src + (size_t)cr * MTOK + ch8 * 8)); v[k] = make_uint4(t4[0], t4[1], t4[2], t4[3]); }
#pragma unroll
  for (int k = 0; k < 2; ++k) {
    int idx = tid + 256 * k; int cr = idx >> 3, ch8 = idx & 7;
#pragma unroll
    for (int q = 0; q < 8; ++q) tile[(ch8 * 8 + q) * 72 + cr] = get16(v[k], q);
  }
  __syncthreads();
#pragma unroll
  for (int k = 0; k < 2; ++k) {
    int idx = tid + 256 * k; int t = idx >> 3, c8 = idx & 7;
    *(uint4*)(y + (size_t)t * DMIX + c8 * 8) = *(const uint4*)(tile + t * 72 + c8 * 8);
  }
  __syncthreads();
}

DI void phase3a(const Params& p, int l, char* smem) {
  constexpr int N0 = 512, N1 = N0 + 384, N2 = N1 + 512, N3 = N2 + 1536;
#ifndef IM
#define IM 0xff
#endif
#ifndef REPI
#define REPI 0
#endif
  for (int item = blockIdx.x; item < N2; item += gridDim.x) {
    int cls = item < N0 ? 0 : item < N1 ? 1 : 2;
    int nr = ((REPI >> cls) & 1) ? 2 : 1;
    for (int rp = 0; rp < nr; ++rp) {
      if (item < N0) { if (IM & 1) hyena_item<2048, 4>(p, l, item, smem); }
      else if (item < N1) { if (IM & 2) ret_kv_item(p, l, item - N0, smem); }
      else { if (IM & 4) hyena_item<256, 16>(p, l, item - N1, smem); }
    }
  }
  {
    int first = blockIdx.x; while (first < N2) first += gridDim.x;
    const int nr = ((REPI >> 3) & 1) ? 2 : 1;
    for (int rp = 0; rp < nr; ++rp) if (IM & 8) lru_items(p, l, 0, first - N2, N3 - N2, smem);
  }
}
DI void phase3b(const Params& p, int l, char* smem) {
  constexpr int N0 = 768, N1 = N0 + 1536, N2 = N1 + 1536;
  for (int item = blockIdx.x; item < N0; item += gridDim.x) {
    int nr = ((REPI >> 4) & 1) ? 2 : 1;
    for (int rp = 0; rp < nr; ++rp) { if (IM & 16) ret_out_item(p, l, item, smem); }
  }
  int first = blockIdx.x; while (first < N0) first += gridDim.x;
  {
    const int nr = ((REPI >> 5) & 1) ? 2 : 1;
    for (int rp = 0; rp < nr; ++rp) if (IM & 32) lru_items(p, l, 1, first - N0, N1 - N0, smem);
  }
  while (first < N1) first += gridDim.x;
  for (int item = first; item < N2; item += gridDim.x) {
    int nr = ((REPI >> 6) & 1) ? 2 : 1;
    for (int rp = 0; rp < nr; ++rp) ytrans_item(p, item - N1, smem);
  }
}

#define XB_TMO      128
#define XB_XCNT(j)  (256  + 64 * (j))
#define XB_XSUB(j)  (1280 + 64 * (j))
#define XB_XGEN(j)  (2304 + 64 * (j))
#define XB_TOP      3328
#define XB_TOPGEN   3392
#define XB_SPIN_CAP (1u << 18)
DI unsigned xb_ld(unsigned* p) { return __hip_atomic_load(p, __ATOMIC_RELAXED, __HIP_MEMORY_SCOPE_AGENT); }
DI unsigned xb_add(unsigned* p, unsigned v) { return __hip_atomic_fetch_add(p, v, __ATOMIC_RELAXED, __HIP_MEMORY_SCOPE_AGENT); }
DI unsigned xb_xcc_id() { return (unsigned)__builtin_amdgcn_s_getreg((3 << 11) | 20) & 0xFu; }
#define XB_SPIN(cond, bar) do { unsigned _sp = 0; while (cond) { __builtin_amdgcn_s_sleep(1); \
    if ((++_sp & 255u) == 0u) { if (xb_ld(&(bar)[XB_TMO])) break; if (_sp > XB_SPIN_CAP) { atomicAdd(&(bar)[XB_TMO], 1u); break; } } } } while (0)
struct XcdBar { unsigned* bar; unsigned x, nloc, nx; };
DI void xcd_complete(unsigned* bar, unsigned x, unsigned& nloc, unsigned& nx) {
  const unsigned G = gridDim.x;
  unsigned sum, cnt, mine, sp = 0u;
  for (;;) {
    sum = 0u; cnt = 0u; mine = 0u;
#pragma unroll
    for (unsigned j = 0; j < 16; ++j) { const unsigned c = xb_ld(&bar[XB_XCNT(j)]); sum += c; cnt += (c > 0u) ? 1u : 0u; mine = (j == x) ? c : mine; }
    if (sum == G) break;
    __builtin_amdgcn_s_sleep(1);
    if ((++sp & 255u) == 0u) { if (xb_ld(&bar[XB_TMO])) break; if (sp > XB_SPIN_CAP) { atomicAdd(&bar[XB_TMO], 1u); break; } }
  }
  nloc = mine > 0u ? mine : 1u; nx = cnt > 0u ? cnt : 1u;
}
DI void xcd_barrier(XcdBar& b) {
  asm volatile("s_waitcnt vmcnt(0)" ::: "memory");
  __syncthreads();
  if (threadIdx.x == 0) {
    unsigned* bar = b.bar;
    __builtin_amdgcn_s_waitcnt(0);
    if (b.nloc == 0u) xcd_complete(bar, b.x, b.nloc, b.nx);
    const unsigned nloc = b.nloc, nx = b.nx;
    const unsigned old = xb_add(&bar[XB_XSUB(b.x)], 1u);
    const unsigned gen = old / nloc;
    if (old + 1u == (gen + 1u) * nloc) {
      __builtin_amdgcn_fence(__ATOMIC_RELEASE, "agent");
      asm volatile("s_waitcnt vmcnt(0)" ::: "memory");
      const unsigned og = xb_add(&bar[XB_TOP], 1u);
      const unsigned tg = og / nx;
      if (og + 1u == (tg + 1u) * nx) xb_add(&bar[XB_TOPGEN], 1u);
      else XB_SPIN(xb_ld(&bar[XB_TOPGEN]) == tg, bar);
      __builtin_amdgcn_fence(__ATOMIC_ACQUIRE, "agent");
      xb_add(&bar[XB_XGEN(b.x)], 1u);
      asm volatile("s_waitcnt vmcnt(0)" ::: "memory");
    } else {
      XB_SPIN(xb_ld(&bar[XB_XGEN(b.x)]) == gen, bar);
      __builtin_amdgcn_fence(__ATOMIC_ACQUIRE, "agent");
      asm volatile("s_waitcnt vmcnt(0)" ::: "memory");
    }
  }
  __syncthreads();
}

constexpr int NPHASE = 14;
#ifndef REPPH
#define REPPH -1
#endif
DI void run_phase(const Params& p, int ph, char* smem) {
  if (ph == 0) {
    for (int idx = blockIdx.x * 256 + threadIdx.x; idx < 2 * 2 * 2048; idx += gridDim.x * 256) ((float*)(p.ws + OFF_CSUM))[idx] = 0.f;
    for (int item = blockIdx.x; item < 1280 + N_MOD; item += gridDim.x) prep_item(p, item < 1280 ? item : PREP_MOD0 + (item - 1280), smem);
  } else if (ph == 1) {
    constexpr int NN = MTOK / 4, NB1 = PREP_MOD0 - 1280, NB2 = N_HID + N_ROPE;
    for (int item = blockIdx.x; item < NN + NB1 + NB2; item += gridDim.x) {
      if (item < NN) norm_item(p, 0, false, item);
      else if (item < NN + NB1) prep_item(p, 1280 + (item - NN), smem);
      else prep_item(p, PREP_MOD0 + N_MOD + (item - NN - NB1), smem);
    }
  } else if (ph == 13) {
    for (int item = blockIdx.x; item < MTOK / 4; item += gridDim.x) norm_item(p, 1, true, item);
  } else {
    const int l = ph >= 8 ? 1 : 0, q = ph >= 8 ? ph - 8 : ph - 2;
    if (ph == 7) { for (int item = blockIdx.x; item < MTOK / 4; item += gridDim.x) norm_item(p, 1, false, item); }
    else if (q == 0) phase_gemm1(p, l, smem);
    else if (q == 1) phase3a(p, l, smem);
    else if (q == 2) { for (int item = blockIdx.x; item < 1280 + 80; item += gridDim.x) { if (item < 1280) ret_scan_item(p, l, item); else lru_scan_item(p, l, item - 1280); } }
    else if (q == 3) phase3b(p, l, smem);
    else phase_gemm2(p, l, smem);
  }
}
__global__ void __launch_bounds__(256, 2) mega(Params p, int ph_lo, int ph_hi, int coop) {
  __shared__ __attribute__((aligned(16))) char smem[65536];
  XcdBar xb; xb.bar = p.bar; xb.x = xb_xcc_id(); xb.nloc = 0u; xb.nx = 0u;
  if (coop) { if (threadIdx.x == 0) (void)xb_add(&p.bar[XB_XCNT(xb.x)], 1u); }
  if (coop == 2) cg::this_grid().sync();
  for (int ph = ph_lo; ph < ph_hi; ++ph) {
    const int nrep = (REPPH >= 0 && ph == REPPH) ? 2 : 1;
    for (int rep = 0; rep < nrep; ++rep) {
      if (rep > 0 && coop) xcd_barrier(xb);
      run_phase(p, ph, smem);
    }
    if (coop && ph + 1 < ph_hi) xcd_barrier(xb);
  }
}

extern "C" void kernel_launch(void* const* d_in, const int* in_sizes, int n_in, void* d_out, int out_size,
                              void* d_ws, size_t ws_size, hipStream_t stream) {
  static int grid_blocks = 0;
  if (!grid_blocks) {
    int dev = 0, cus = 0, per_cu = 0;
    hipGetDevice(&dev);
    hipDeviceGetAttribute(&cus, hipDeviceAttributeMultiprocessorCount, dev);
    hipOccupancyMaxActiveBlocksPerMultiprocessor(&per_cu, mega, 256, 0);
    if (per_cu < 1) per_cu = 1;
    if (per_cu > 2) per_cu = 2;
    grid_blocks = cus * per_cu;
  }
  Params p{};
  for (int i = 0; i < 27; ++i) p.in[i] = (const float*)d_in[i];
  p.out = (float*)d_out; p.ws = (char*)d_ws; p.bar = (unsigned*)((char*)d_ws + OFF_BAR);
  (void)hipMemsetAsync((char*)d_ws + OFF_BAR, 0, BAR_BYTES, stream);
  if (ws_size < WS_TOTAL) fprintf(stderr, "workspace too small: %zu < %zu\n", ws_size, (size_t)WS_TOTAL);
#if COOP
  int lo = 0, hi = NPHASE, coop = 1;
  void* args[] = {&p, &lo, &hi, &coop};
  hipError_t e = hipLaunchCooperativeKernel((void*)mega, dim3(grid_blocks), dim3(256), args, 0, stream);
  if (e != hipSuccess) fprintf(stderr, "cooperative launch failed: %s (grid %d)\n", hipGetErrorString(e), grid_blocks);
#else
  for (int ph = 0; ph < NPHASE; ++ph) hipLaunchKernelGGL(mega, dim3(grid_blocks), dim3(256), 0, stream, p, ph, ph + 1, 0);
#endif
}
```

```cpp
#include <hip/hip_runtime.h>
#include <hip/hip_bf16.h>
#include <hip/hip_cooperative_groups.h>
#include <cstdio>
#include <type_traits>
namespace cg = cooperative_groups;

#ifndef COOP
#define COOP 1
#endif

typedef unsigned short u16;
using bf16x8 = __attribute__((ext_vector_type(8))) short;
using f32x4 = __attribute__((ext_vector_type(4))) float;
using f32x16 = __attribute__((ext_vector_type(16))) float;
using u32x4 = __attribute__((ext_vector_type(4))) unsigned;
using u32x32 = __attribute__((ext_vector_type(32))) unsigned;
#define DI __device__ __forceinline__

constexpr int D = 1024, MTOK = 12288, MCTX = 4096, DIN = 5120, DMIX = 1536;
constexpr int ZRL_LD = 3072;
constexpr float EPSF = 1e-6f;
constexpr size_t OFF_HY   = 0;
constexpr size_t OFF_ZRL  = OFF_HY   + (size_t)MTOK * 1536 * 2;
constexpr size_t OFF_ZT   = OFF_ZRL  + (size_t)MTOK * ZRL_LD * 2;
constexpr size_t OFF_WIN  = OFF_ZT   + (size_t)2048 * MTOK * 2;
constexpr size_t OFF_WOUT = OFF_WIN  + (size_t)2 * DIN * D * 2;
constexpr size_t OFF_FILT = OFF_WOUT + (size_t)2 * D * DMIX * 2;
constexpr size_t OFF_KV   = OFF_FILT + (size_t)8 * 512 * 2304 * 2;
constexpr size_t OFF_MOD  = OFF_KV   + (size_t)96 * 8 * 16384 * 2;
constexpr size_t OFF_HID2 = OFF_MOD  + (size_t)2 * 5 * 3072 * 4;
constexpr size_t OFF_ROPE = OFF_HID2 + (size_t)2 * 2304 * 64 * 4;
constexpr size_t OFF_GWT  = OFF_ROPE + (size_t)2 * 2048 * 64 * 4;
constexpr size_t OFF_LRUS = OFF_GWT  + (size_t)64 * 4096 * 2;
constexpr size_t OFF_CSUM = OFF_LRUS + (size_t)192 * 2 * 2 * 512 * 4;
constexpr size_t OFF_BAR  = OFF_CSUM + (size_t)2 * 2 * 2048 * 4;
constexpr size_t BAR_BYTES = 3456 * 4;
constexpr size_t OFF_YT   = OFF_BAR + 16384;
constexpr size_t WS_TOTAL = OFF_YT + (size_t)512 * MTOK * 2;

struct Params { const float* in[27]; float* out; char* ws; unsigned* bar; };

enum { I_XP = 0, I_XS, I_SRET, I_SLRU, I_C, I_CCTX, I_NORMG, I_ADAW, I_ADAB, I_WIN, I_RLOGIT, I_HCW, I_HCB,
       I_HW1, I_HB1, I_HW2, I_HB2, I_HW3, I_HFREQ, I_HBIAS, I_LCW, I_LCB, I_LGW, I_LGB, I_LLAM, I_WOUT, I_FING };

constexpr size_t OUT_SRET = (size_t)MTOK * D;
constexpr size_t OUT_SLRU = OUT_SRET + (size_t)16 * 2 * 2 * 4 * 16384;

typedef __bf16 bf16x2_t __attribute__((ext_vector_type(2)));
typedef float f32x2_t __attribute__((ext_vector_type(2)));
DI u16 f2bf(float x) { __bf16 r = (__bf16)x; return __builtin_bit_cast(u16, r); }
DI float bf2f(u16 v) { return __uint_as_float(((unsigned)v) << 16); }
DI unsigned pack2(float a, float b) { f32x2_t v = {a, b}; bf16x2_t r = __builtin_convertvector(v, bf16x2_t); return __builtin_bit_cast(unsigned, r); }
DI float siluf(float x) { return x * __builtin_amdgcn_rcpf(1.f + __expf(-x)); }
DI float sigmf(float x) { return __builtin_amdgcn_rcpf(1.f + __expf(-x)); }
DI int crow(int i, int h) { return (i & 3) + 8 * (i >> 2) + 4 * h; }
DI f32x16 mfma32(bf16x8 a, bf16x8 b, f32x16 c) { return __builtin_amdgcn_mfma_f32_32x32x16_bf16(a, b, c, 0, 0, 0); }
DI f32x4 mfma16(bf16x8 a, bf16x8 b, f32x4 c) { return __builtin_amdgcn_mfma_f32_16x16x32_bf16(a, b, c, 0, 0, 0); }
DI int swz(int row, int col) { return row * 128 + ((((col >> 3) ^ (row & 15)) << 3) | (col & 7)); }
DI int swz64(int row, int col) { return row * 64 + ((((col >> 3) ^ (row & 7)) << 3) | (col & 7)); }
DI bf16x8 ldfrag(const u16* buf, int row, int col8) { return *(const bf16x8*)(buf + swz(row, col8)); }
DI f32x16 zero16() { f32x16 z; for (int i = 0; i < 16; ++i) z[i] = 0.f; return z; }
DI void unpack8(uint4 v, float* f) {
  f[0] = __uint_as_float(v.x << 16); f[1] = __uint_as_float(v.x & 0xffff0000u);
  f[2] = __uint_as_float(v.y << 16); f[3] = __uint_as_float(v.y & 0xffff0000u);
  f[4] = __uint_as_float(v.z << 16); f[5] = __uint_as_float(v.z & 0xffff0000u);
  f[6] = __uint_as_float(v.w << 16); f[7] = __uint_as_float(v.w & 0xffff0000u);
}
DI uint4 pack8(const float* f) { uint4 v; v.x = pack2(f[0], f[1]); v.y = pack2(f[2], f[3]); v.z = pack2(f[4], f[5]); v.w = pack2(f[6], f[7]); return v; }
DI int get_tid() { int t = threadIdx.x; asm volatile("" : "+v"(t)); return t; }
DI u16 get16(const uint4& v, int q) { unsigned wv = (q >> 1) == 0 ? v.x : (q >> 1) == 1 ? v.y : (q >> 1) == 2 ? v.z : v.w; return (u16)((q & 1) ? (wv >> 16) : (wv & 0xffffu)); }
DI unsigned pair16(const uint4& a, const uint4& b, int q) {
  unsigned wa = (q >> 1) == 0 ? a.x : (q >> 1) == 1 ? a.y : (q >> 1) == 2 ? a.z : a.w;
  unsigned wb = (q >> 1) == 0 ? b.x : (q >> 1) == 1 ? b.y : (q >> 1) == 2 ? b.z : b.w;
  return (q & 1) ? ((wa >> 16) | (wb & 0xffff0000u)) : ((wa & 0xffffu) | (wb << 16));
}
DI float logsig(float x) { return -log1pf(expf(-x)); }

DI void transpose_tile(const float* src, int lds_, u16* dst, int ldd, char* smem) {
  float* tile = (float*)smem;
  const int tid = get_tid();
  float4 v[4];
#pragma unroll
  for (int i = 0; i < 4; ++i) {
    int idx = i * 256 + tid; int r = idx >> 4, c4 = idx & 15;
    f32x4 t4 = __builtin_nontemporal_load((const f32x4*)(src + (size_t)r * lds_ + c4 * 4));
    v[i] = make_float4(t4[0], t4[1], t4[2], t4[3]);
  }
#pragma unroll
  for (int i = 0; i < 4; ++i) {
    int idx = i * 256 + tid; int r = idx >> 4, c4 = idx & 15;
    tile[r * 65 + c4 * 4] = v[i].x; tile[r * 65 + c4 * 4 + 1] = v[i].y; tile[r * 65 + c4 * 4 + 2] = v[i].z; tile[r * 65 + c4 * 4 + 3] = v[i].w;
  }
  __syncthreads();
#pragma unroll
  for (int i = 0; i < 2; ++i) {
    int idx = i * 256 + tid; int kc = idx & 7, c = idx >> 3;
    float f[8];
#pragma unroll
    for (int q = 0; q < 8; ++q) f[q] = tile[(kc * 8 + q) * 65 + c];
    *(uint4*)(dst + (size_t)c * ldd + kc * 8) = pack8(f);
  }
  __syncthreads();
}

constexpr int N_TW = 2 * 16 * 80, N_TO = 2 * 24 * 16, N_TG = 64, N_MOD = 384, N_HID = 1152, N_ROPE = 512;
constexpr int PREP_MOD0 = N_TW + N_TO + N_TG, PREP_TOTAL = PREP_MOD0 + N_MOD + N_HID + N_ROPE;
DI void prep_item(const Params& p, int item, char* smem) {
  const int tid = get_tid();
  do {
    int it = item;
    if (it < N_TW) {
      int l = it / 1280, rem = it % 1280, kt = rem / 80, nt = rem % 80;
      transpose_tile(p.in[I_WIN] + ((size_t)l * D + kt * 64) * DIN + nt * 64, DIN,
                     (u16*)(p.ws + OFF_WIN) + ((size_t)l * DIN + nt * 64) * D + kt * 64, D, smem);
      continue;
    }
    it -= N_TW;
    if (it < N_TO) {
      int l = it / 384, rem = it % 384, kt = rem / 16, nt = rem % 16;
      transpose_tile(p.in[I_WOUT] + ((size_t)l * DMIX + kt * 64) * D + nt * 64, D,
                     (u16*)(p.ws + OFF_WOUT) + ((size_t)l * D + nt * 64) * DMIX + kt * 64, DMIX, smem);
      continue;
    }
    it -= N_TO;
    if (it < N_TG) {
      transpose_tile(p.in[I_LGW] + (size_t)it * 4096, 64, (u16*)(p.ws + OFF_GWT) + (size_t)it * 4096, 64, smem);
      continue;
    }
    it -= N_TG;
    if (it < N_MOD) {
      int l = it / 192, j0 = (it % 192) * 16;
      float* sc = (float*)smem;
      float* red = sc + 5 * 1024;
      for (int idx = tid; idx < 5120; idx += 256) {
        int bb = idx >> 10, k = idx & 1023;
        float cv = bb == 0 ? p.in[I_CCTX][k] : p.in[I_C][(bb - 1) * 1024 + k];
        sc[idx] = cv / (1.f + expf(-cv));
      }
      __syncthreads();
      int col = tid & 15, kp = tid >> 4;
      float a0 = 0, a1 = 0, a2 = 0, a3 = 0, a4 = 0;
      const float* wp = p.in[I_ADAW] + ((size_t)l * D + kp * 64) * 3072 + j0 + col;
#pragma unroll 16
      for (int k = 0; k < 64; ++k) {
        float w = __builtin_nontemporal_load(wp + (size_t)k * 3072); int kk = kp * 64 + k;
        a0 += sc[kk] * w; a1 += sc[1024 + kk] * w; a2 += sc[2048 + kk] * w; a3 += sc[3072 + kk] * w; a4 += sc[4096 + kk] * w;
      }
      red[(kp * 5 + 0) * 16 + col] = a0; red[(kp * 5 + 1) * 16 + col] = a1; red[(kp * 5 + 2) * 16 + col] = a2;
      red[(kp * 5 + 3) * 16 + col] = a3; red[(kp * 5 + 4) * 16 + col] = a4;
      __syncthreads();
      if (tid < 80) {
        int bb = tid >> 4, cc = tid & 15; float sm = 0.f;
#pragma unroll
        for (int q = 0; q < 16; ++q) sm += red[(q * 5 + bb) * 16 + cc];
        ((float*)(p.ws + OFF_MOD))[(l * 5 + bb) * 3072 + j0 + cc] = sm + p.in[I_ADAB][l * 3072 + j0 + cc];
      }
      __syncthreads();
      continue;
    }
    it -= N_MOD;
    if (it < N_HID) {
      int l = it / 576, rg = it % 576;
      int rr = rg * 4 + (tid >> 6), o = tid & 63, rw = tid >> 6;
      int L = rr < 256 ? 256 : 2048, pos = rr < 256 ? rr : rr - 256;
      float* zb = (float*)smem;
      float* h1 = zb + 4 * 36;
      if (o < 33) {
        float v;
        if (o == 0) v = (float)pos / (float)(L - 1);
        else {
          int i = (o - 1) & 15;
          float f = 1e-4f + (float)i * ((15.f - 1e-4f) / 15.f);
          float w0 = (L == 256) ? (float)(6.283185307179586 / 256.0) : (float)(6.283185307179586 / 2048.0);
          float ang = (w0 * (float)pos) * f;
          v = (o <= 16) ? cosf(ang) : -sinf(ang);
        }
        zb[rw * 36 + o] = v;
      }
      __syncthreads();
      {
        float acc = p.in[I_HB1][l * 64 + o];
        const float* w1 = p.in[I_HW1] + (size_t)l * 33 * 64 + o;
        float wv[33];
#pragma unroll
        for (int i = 0; i < 33; ++i) wv[i] = w1[i * 64];
#pragma unroll
        for (int i = 0; i < 33; ++i) acc += zb[rw * 36 + i] * wv[i];
        h1[rw * 64 + o] = sinf(p.in[I_HFREQ][(l * 2 + 0) * 64 + o] * acc);
      }
      __syncthreads();
      {
        float acc = p.in[I_HB2][l * 64 + o];
        const float* w2 = p.in[I_HW2] + (size_t)l * 64 * 64 + o;
        float wv[64];
#pragma unroll
        for (int i = 0; i < 64; ++i) wv[i] = w2[i * 64];
#pragma unroll
        for (int i = 0; i < 64; ++i) acc += h1[rw * 64 + i] * wv[i];
        ((float*)(p.ws + OFF_HID2))[((size_t)l * 2304 + rr) * 64 + o] = sinf(p.in[I_HFREQ][(l * 2 + 1) * 64 + o] * acc);
      }
      __syncthreads();
      continue;
    }
    it -= N_HID;
    {
      int idx = it * 256 + tid; int pp = idx >> 6, i = idx & 63;
      float inv = powf(10000.f, -(float)(i & 31) / 32.f);
      float ang = (i < 32 ? (float)(pp >> 6) : (float)(pp & 63)) * inv;
      float* rp = (float*)(p.ws + OFF_ROPE);
      rp[idx] = cosf(ang); rp[2048 * 64 + idx] = sinf(ang);
    }
  } while (0);
}


DI void split8(const float* f, bf16x8& hi, bf16x8& lo) {
#pragma unroll
  for (int q = 0; q < 8; ++q) { u16 hb = f2bf(f[q]); hi[q] = (short)hb; lo[q] = (short)f2bf(f[q] - bf2f(hb)); }
}
DI void filt_item(const Params& p, int item) {
  const int tid = get_tid(), lane = tid & 63, w = tid >> 6, r = lane & 31, h = lane >> 5;
  {
    int l = item / 576, rem = item % 576, chunk = rem >> 6, cgp = rem & 63;
    int ls = chunk > 0, L = ls ? 2048 : 256, rowbase = ls ? 256 : 0, posc = ls ? (chunk - 1) * 256 : 0;
    int col = cgp * 32 + r;
    int ord = col >> 10, dir = (col >> 9) & 1, c = col & 511;
    bf16x8 bh[4], bl[4];
#pragma unroll
    for (int ks = 0; ks < 4; ++ks) {
      float f[8];
#pragma unroll
      for (int q = 0; q < 8; ++q) f[q] = p.in[I_HW3][((size_t)l * 64 + ks * 16 + 8 * h + q) * 2048 + col];
      split8(f, bh[ks], bl[ks]);
    }
    const float mind = logf(1e-2f) / 1.5f, maxd = logf(1e-2f) / 0.3f;
    float delta = fabsf(mind + (float)c * ((maxd - mind) / 511.f));
    float invLm1 = 1.f / (float)(L - 1);
    u16* dst = (u16*)(p.ws + OFF_FILT) + ((size_t)((l * 2 + ord) * 2 + dir) * 512 + c) * 2304 + rowbase;
    float asum = 0.f;
    float4 hq[2][4][2];
#pragma unroll
    for (int tt = 0; tt < 2; ++tt) {
      const float* hrow = (const float*)(p.ws + OFF_HID2) + ((size_t)l * 2304 + rowbase + posc + (w * 2 + tt) * 32 + r) * 64;
#pragma unroll
      for (int ks = 0; ks < 4; ++ks) { hq[tt][ks][0] = *(const float4*)(hrow + ks * 16 + 8 * h); hq[tt][ks][1] = *(const float4*)(hrow + ks * 16 + 8 * h + 4); }
    }
#pragma unroll
    for (int tt = 0; tt < 2; ++tt) {
      int pos0 = posc + (w * 2 + tt) * 32;
      f32x16 acc = zero16();
#pragma unroll
      for (int ks = 0; ks < 4; ++ks) {
        float4 x0 = hq[tt][ks][0], x1 = hq[tt][ks][1];
        float f[8] = {x0.x, x0.y, x0.z, x0.w, x1.x, x1.y, x1.z, x1.w};
        bf16x8 ah, al; split8(f, ah, al);
        acc = mfma32(ah, bh[ks], acc); acc = mfma32(ah, bl[ks], acc); acc = mfma32(al, bh[ks], acc);
      }
#pragma unroll
      for (int g = 0; g < 4; ++g) {
        float o[4];
#pragma unroll
        for (int q = 0; q < 4; ++q) {
          int pos = pos0 + 8 * g + 4 * h + q;
          float hv = acc[4 * g + q] * __expf(-((float)pos * invLm1) * delta);
          asum += fabsf(hv); o[q] = hv;
        }
        uint2 o2; o2.x = pack2(o[0], o[1]); o2.y = pack2(o[2], o[3]);
        *(uint2*)(dst + pos0 + 8 * g + 4 * h) = o2;
      }
    }
    asum += __shfl_xor(asum, 32);
    if (h == 0) atomicAdd((float*)(p.ws + OFF_CSUM) + (l * 2 + ls) * 2048 + col, asum);
  }
}

DI void norm_item(const Params& p, int l, bool fin, int item) {
  const int tid = get_tid(), lane = tid & 63, wv = tid >> 6;
  {
    int m = item * 4 + wv;
    const float* src = (l == 0 && !fin) ? (m < MCTX ? p.in[I_XP] + (size_t)m * D : p.in[I_XS] + (size_t)(m - MCTX) * D)
                                        : p.out + (size_t)m * D;
    float4 v[4]; float ss = 0.f;
#pragma unroll
    for (int i = 0; i < 4; ++i) { v[i] = *(const float4*)(src + (i * 64 + lane) * 4); ss += v[i].x * v[i].x + v[i].y * v[i].y + v[i].z * v[i].z + v[i].w * v[i].w; }
    for (int o = 32; o >= 1; o >>= 1) ss += __shfl_xor(ss, o);
    float rstd = rsqrtf(ss * (1.f / 1024.f) + EPSF);
    if (fin) {
      float* dst = p.out + (size_t)m * D;
      float4 gq[4];
#pragma unroll
      for (int i = 0; i < 4; ++i) gq[i] = *(const float4*)(p.in[I_FING] + (i * 64 + lane) * 4);
#pragma unroll
      for (int i = 0; i < 4; ++i) {
        int n = (i * 64 + lane) * 4; float4 g = gq[i];
        f32x4 o4 = {v[i].x * rstd * g.x, v[i].y * rstd * g.y, v[i].z * rstd * g.z, v[i].w * rstd * g.w};
        __builtin_nontemporal_store(o4, (f32x4*)(dst + n));
      }
    } else {
      int bb = m < MCTX ? 0 : 1 + ((m - MCTX) >> 11);
      const float* modp = (const float*)(p.ws + OFF_MOD) + (l * 5 + bb) * 3072;
      u16* dst = (u16*)(p.ws + OFF_HY) + (size_t)m * D;
      float4 gq[4], shq[4], scq[4];
#pragma unroll
      for (int i = 0; i < 4; ++i) { int n = (i * 64 + lane) * 4; gq[i] = *(const float4*)(p.in[I_NORMG] + l * D + n); shq[i] = *(const float4*)(modp + n); scq[i] = *(const float4*)(modp + 1024 + n); }
#pragma unroll
      for (int i = 0; i < 4; ++i) {
        int n = (i * 64 + lane) * 4;
        float4 g = gq[i];
        float4 sh = shq[i], sc = scq[i];
        float a = v[i].x * rstd * g.x * (1.f + sc.x) + sh.x, b = v[i].y * rstd * g.y * (1.f + sc.y) + sh.y;
        float c = v[i].z * rstd * g.z * (1.f + sc.z) + sh.z, d = v[i].w * rstd * g.w * (1.f + sc.w) + sh.w;
        uint2 o2; o2.x = pack2(a, b); o2.y = pack2(c, d);
        *(uint2*)(dst + n) = o2;
      }
    }
  }
}

DI void glds16(const void* g, void* l) { __builtin_amdgcn_global_load_lds((const unsigned*)g, (unsigned*)l, 16, 0, 0); }

template <int MODE, int MT>
DI void gemm_tile(const Params& p, int l, const u16* A, int lda, const u16* Bt, int ldb, int K, int brow, int bcol, char* smem) {
  const int tid = get_tid(), lane = tid & 63, wid = tid >> 6, wr = wid >> 1, wc = wid & 1, fr = lane & 15, fq = lane >> 4;
  f32x4 acc[MT][4];
#pragma unroll
  for (int m = 0; m < MT; ++m)
#pragma unroll
    for (int n = 0; n < 4; ++n) acc[m][n] = f32x4{0.f, 0.f, 0.f, 0.f};
  const int nt = K / 64;
  auto stage = [&](int kt, int b) {
    char* sa = smem + b * 32768; char* sb = sa + 16384;
#pragma unroll
    for (int i = 0; i < 4; ++i) {
      int byte = tid * 16 + i * 4096; int r = byte >> 7, cp = (byte & 127) >> 4, c = cp ^ (r & 7);
      if (i < MT) glds16(A + (size_t)(brow + r) * lda + kt * 64 + c * 8, sa + byte);
      glds16(Bt + (size_t)(bcol + r) * ldb + kt * 64 + c * 8, sb + byte);
    }
  };
  asm volatile("s_waitcnt vmcnt(0)" ::: "memory");
  stage(0, 0);
  stage(1, 1);
  for (int t = 0; t < nt; ++t) {
    if (t + 1 < nt) { if (MT == 4) asm volatile("s_waitcnt vmcnt(8)" ::: "memory"); else if (MT == 3) asm volatile("s_waitcnt vmcnt(7)" ::: "memory"); else asm volatile("s_waitcnt vmcnt(6)" ::: "memory"); }
    else asm volatile("s_waitcnt vmcnt(0)" ::: "memory");
    __builtin_amdgcn_s_barrier();
    const char* sa = smem + (t & 1) * 32768; const char* sb = sa + 16384;
    bf16x8 af[2][MT], bfr[2][4];
#pragma unroll
    for (int ks = 0; ks < 2; ++ks) {
#pragma unroll
      for (int m = 0; m < MT; ++m) { int R = wr * (16 * MT) + m * 16 + fr; af[ks][m] = *(const bf16x8*)(sa + R * 128 + (((ks * 4 + fq) ^ (R & 7)) << 4)); }
#pragma unroll
      for (int n = 0; n < 4; ++n) { int R = wc * 64 + n * 16 + fr; bfr[ks][n] = *(const bf16x8*)(sb + R * 128 + (((ks * 4 + fq) ^ (R & 7)) << 4)); }
      __builtin_amdgcn_sched_barrier(0);
    }
#pragma unroll
    for (int ks = 0; ks < 2; ++ks) {
      if (ks == 1) {
        asm volatile("s_waitcnt lgkmcnt(0)" ::: "memory");
        __builtin_amdgcn_s_barrier();
        if (t + 2 < nt) stage(t + 2, t & 1);
        __builtin_amdgcn_sched_barrier(0);
      }
      __builtin_amdgcn_s_setprio(1);
#pragma unroll
      for (int m = 0; m < MT; ++m)
#pragma unroll
        for (int n = 0; n < 4; ++n) {
          if (MODE == 1) acc[m][n] = mfma16(af[ks][m], bfr[ks][n], acc[m][n]);
          else           acc[m][n] = mfma16(bfr[ks][n], af[ks][m], acc[m][n]);
        }
      __builtin_amdgcn_s_setprio(0);
      __builtin_amdgcn_sched_barrier(0);
    }
  }
  if (MODE == 0) {
    u16* z = (u16*)(p.ws + OFF_ZRL);
    int cb = bcol < 2048 ? bcol : bcol - 2048;
#pragma unroll
    for (int m = 0; m < MT; ++m)
#pragma unroll
      for (int n = 0; n < 4; ++n) {
        int mrow = brow + wr * (16 * MT) + m * 16 + fr, ncol = cb + wc * 64 + n * 16 + fq * 4;
        uint2 o; o.x = pack2(acc[m][n][0], acc[m][n][1]); o.y = pack2(acc[m][n][2], acc[m][n][3]);
        *(uint2*)(z + (size_t)mrow * ZRL_LD + ncol) = o;
      }
  } else if (MODE == 1) {
    u16* zt = (u16*)(p.ws + OFF_ZT);
#pragma unroll
    for (int m = 0; m < MT; ++m)
#pragma unroll
      for (int n = 0; n < 4; ++n) {
        int mrow = brow + wr * (16 * MT) + m * 16 + fq * 4, ch = bcol - 2048 + wc * 64 + n * 16 + fr;
        uint2 o; o.x = pack2(acc[m][n][0], acc[m][n][1]); o.y = pack2(acc[m][n][2], acc[m][n][3]);
        *(uint2*)(zt + (size_t)ch * MTOK + mrow) = o;
      }
  } else {
    float4 xq[MT][4], gq[MT][4];
#pragma unroll
    for (int m = 0; m < MT; ++m) {
      int mrow = brow + wr * (16 * MT) + m * 16 + fr;
      int bb = mrow < MCTX ? 0 : 1 + ((mrow - MCTX) >> 11);
      const float* gate = (const float*)(p.ws + OFF_MOD) + (l * 5 + bb) * 3072 + 2048;
      const float* xs = (l == 0) ? (mrow < MCTX ? p.in[I_XP] + (size_t)mrow * D : p.in[I_XS] + (size_t)(mrow - MCTX) * D)
                                 : p.out + (size_t)mrow * D;
#pragma unroll
      for (int n = 0; n < 4; ++n) { int ncol = bcol + wc * 64 + n * 16 + fq * 4; xq[m][n] = *(const float4*)(xs + ncol); gq[m][n] = *(const float4*)(gate + ncol); }
    }
#pragma unroll
    for (int m = 0; m < MT; ++m) {
      int mrow = brow + wr * (16 * MT) + m * 16 + fr;
      float* xd = p.out + (size_t)mrow * D;
#pragma unroll
      for (int n = 0; n < 4; ++n) {
        int ncol = bcol + wc * 64 + n * 16 + fq * 4;
        float4 xv = xq[m][n], gv = gq[m][n];
        float4 o = make_float4(xv.x + gv.x * acc[m][n][0], xv.y + gv.y * acc[m][n][1], xv.z + gv.z * acc[m][n][2], xv.w + gv.w * acc[m][n][3]);
        *(float4*)(xd + ncol) = o;
      }
    }
  }
  __syncthreads();
}

template <int MODE>
DI void gemm_tile_big(const Params& p, int l, const u16* A, int lda, const u16* Bt, int ldb, int K, int brow, int bcol, char* smem) {
  const int tid = get_tid(), lane = tid & 63, w = tid >> 6, fr = lane & 15, fq = lane >> 4;
  f32x4 acc[4][8];
#pragma unroll
  for (int m = 0; m < 4; ++m)
#pragma unroll
    for (int n = 0; n < 8; ++n) acc[m][n] = f32x4{0.f, 0.f, 0.f, 0.f};
  const int nt = K / 32;
  auto stage = [&](int kt, int b) {
    char* sa = smem + b * 24576; char* sb = sa + 16384;
#pragma unroll
    for (int i = 0; i < 4; ++i) {
      int byte = tid * 16 + i * 4096; int r = byte >> 6, cp = (byte & 63) >> 4, c = cp ^ ((r >> 2) & 3);
      glds16(A + (size_t)(brow + r) * lda + kt * 32 + c * 8, sa + byte);
      if (i < 2) glds16(Bt + (size_t)(bcol + r) * ldb + kt * 32 + c * 8, sb + byte);
    }
  };
  stage(0, 0);
  for (int t = 0; t < nt; ++t) {
    asm volatile("s_waitcnt vmcnt(0)" ::: "memory");
    __syncthreads();
    if (t + 1 < nt) stage(t + 1, (t + 1) & 1);
    const char* sa = smem + (t & 1) * 24576; const char* sb = sa + 16384;
    bf16x8 af[4], bfr[8];
#pragma unroll
    for (int m = 0; m < 4; ++m) { int R = w * 64 + m * 16 + fr; af[m] = *(const bf16x8*)(sa + R * 64 + ((fq ^ ((R >> 2) & 3)) << 4)); }
#pragma unroll
    for (int n = 0; n < 8; ++n) { int R = n * 16 + fr; bfr[n] = *(const bf16x8*)(sb + R * 64 + ((fq ^ ((R >> 2) & 3)) << 4)); }
    __builtin_amdgcn_sched_barrier(0);
    __builtin_amdgcn_s_setprio(1);
#pragma unroll
    for (int m = 0; m < 4; ++m)
#pragma unroll
      for (int n = 0; n < 8; ++n) {
        if (MODE == 1) acc[m][n] = mfma16(af[m], bfr[n], acc[m][n]);
        else           acc[m][n] = mfma16(bfr[n], af[m], acc[m][n]);
      }
    __builtin_amdgcn_s_setprio(0);
    __builtin_amdgcn_sched_barrier(0);
  }
  if (MODE == 0) {
    u16* z = (u16*)(p.ws + OFF_ZRL);
    int cb = bcol < 2048 ? bcol : bcol - 2048;
#pragma unroll
    for (int m = 0; m < 4; ++m)
#pragma unroll
      for (int n = 0; n < 8; ++n) {
        int mrow = brow + w * 64 + m * 16 + fr, ncol = cb + n * 16 + fq * 4;
        uint2 o; o.x = pack2(acc[m][n][0], acc[m][n][1]); o.y = pack2(acc[m][n][2], acc[m][n][3]);
        *(uint2*)(z + (size_t)mrow * ZRL_LD + ncol) = o;
      }
  } else if (MODE == 1) {
    u16* zt = (u16*)(p.ws + OFF_ZT);
#pragma unroll
    for (int m = 0; m < 4; ++m)
#pragma unroll
      for (int n = 0; n < 8; ++n) {
        int mrow = brow + w * 64 + m * 16 + fq * 4, ch = bcol - 2048 + n * 16 + fr;
        uint2 o; o.x = pack2(acc[m][n][0], acc[m][n][1]); o.y = pack2(acc[m][n][2], acc[m][n][3]);
        *(uint2*)(zt + (size_t)ch * MTOK + mrow) = o;
      }
  } else {
#pragma unroll
    for (int m = 0; m < 4; ++m) {
      int mrow = brow + w * 64 + m * 16 + fr;
      int bb = mrow < MCTX ? 0 : 1 + ((mrow - MCTX) >> 11);
      const float* gate = (const float*)(p.ws + OFF_MOD) + (l * 5 + bb) * 3072 + 2048;
      const float* xs = (l == 0) ? (mrow < MCTX ? p.in[I_XP] + (size_t)mrow * D : p.in[I_XS] + (size_t)(mrow - MCTX) * D)
                                 : p.out + (size_t)mrow * D;
      float* xd = p.out + (size_t)mrow * D;
      float4 xq[8], gq[8];
#pragma unroll
      for (int n = 0; n < 8; ++n) { int ncol = bcol + n * 16 + fq * 4; xq[n] = *(const float4*)(xs + ncol); gq[n] = *(const float4*)(gate + ncol); }
#pragma unroll
      for (int n = 0; n < 8; ++n) {
        int ncol = bcol + n * 16 + fq * 4;
        float4 xv = xq[n], gv = gq[n];
        float4 o = make_float4(xv.x + gv.x * acc[m][n][0], xv.y + gv.y * acc[m][n][1], xv.z + gv.z * acc[m][n][2], xv.w + gv.w * acc[m][n][3]);
        *(float4*)(xd + ncol) = o;
      }
    }
  }
  __syncthreads();
}

DI void phase_gemm1(const Params& p, int l, char* smem) {
  const u16* A = (const u16*)(p.ws + OFF_HY);
  const u16* Bt = (const u16*)(p.ws + OFF_WIN) + (size_t)l * DIN * D;
  if (gridDim.x == 512) {
    const int x = blockIdx.x & 7, j = blockIdx.x >> 3;
    for (int k = 0; k < 8; ++k) {
      int st, i = j & 7, jj = j >> 3;
      if (k < 7) st = k * 8 + x;
      else { if (j >= 32) break; st = 56 + (x >> 1); jj = (j >> 3) + 4 * (x & 1); }
      int mt = (st / 5) * 8 + i, ntile = (st % 5) * 8 + jj;
      int brow = mt * 128, bcol = ntile * 128;
      if (bcol >= 2048 && bcol < 4096) gemm_tile<1, 4>(p, l, A, D, Bt, D, D, brow, bcol, smem);
      else                             gemm_tile<0, 4>(p, l, A, D, Bt, D, D, brow, bcol, smem);
    }
    if (l == 0) {
      const int fb = (j >= 32) ? (x * 32 + (j - 32)) : (256 + x * 32 + j);
      for (int it = fb; it < 1152; it += 512) filt_item(p, it);
    }
    return;
  }
  const int nitems = 96 * 40 + (l == 0 ? 1152 : 0);
  for (int t = blockIdx.x; t < nitems; t += gridDim.x) {
    if (t >= 96 * 40) { filt_item(p, t - 96 * 40); continue; }
    int mt = t / 40, ntile = t % 40;
    int brow = mt * 128, bcol = ntile * 128;
    if (bcol >= 2048 && bcol < 4096) gemm_tile<1, 4>(p, l, A, D, Bt, D, D, brow, bcol, smem);
    else                             gemm_tile<0, 4>(p, l, A, D, Bt, D, D, brow, bcol, smem);
  }
}
DI void phase_gemm2(const Params& p, int l, char* smem) {
  const u16* A = (const u16*)(p.ws + OFF_HY);
  const u16* Bt = (const u16*)(p.ws + OFF_WOUT) + (size_t)l * D * DMIX;
  if (gridDim.x == 512) {
    const int x = blockIdx.x & 7, j = blockIdx.x >> 3;
    for (int k = 0; k < 2; ++k) {
      int mt = (k * 8 + x) * 8 + (j & 7), ntile = j >> 3;
      gemm_tile<2, 3>(p, l, A, DMIX, Bt, DMIX, DMIX, mt * 96, ntile * 128, smem);
    }
    return;
  }
  for (int t = blockIdx.x; t < 128 * 8; t += gridDim.x) {
    int mt = t / 8, ntile = t % 8;
    gemm_tile<2, 3>(p, l, A, DMIX, Bt, DMIX, DMIX, mt * 96, ntile * 128, smem);
  }
}

struct RopeRaw { uint4 va, vb; float4 c0, c1, s0, s1; };
DI void rope_load(const Params& p, const u16* zrow, int d0, bool sample, int pos, RopeRaw& rr) {
  rr.va = *(const uint4*)(zrow + d0); rr.vb = *(const uint4*)(zrow + d0 + 64);
  if (sample) {
    const float* cs = (const float*)(p.ws + OFF_ROPE) + (size_t)pos * 64 + d0;
    const float* sn = cs + 2048 * 64;
    rr.c0 = *(const float4*)cs; rr.c1 = *(const float4*)(cs + 4); rr.s0 = *(const float4*)sn; rr.s1 = *(const float4*)(sn + 4);
  }
}
DI void rope_finish(const RopeRaw& rr, bool sample, float* a, float* b) {
  unpack8(rr.va, a); unpack8(rr.vb, b);
  if (sample) {
    const float c[8] = {rr.c0.x, rr.c0.y, rr.c0.z, rr.c0.w, rr.c1.x, rr.c1.y, rr.c1.z, rr.c1.w};
    const float s[8] = {rr.s0.x, rr.s0.y, rr.s0.z, rr.s0.w, rr.s1.x, rr.s1.y, rr.s1.z, rr.s1.w};
#pragma unroll
    for (int q = 0; q < 8; ++q) { float x = a[q], y = b[q]; a[q] = x * c[q] - y * s[q]; b[q] = x * s[q] + y * c[q]; }
  }
}

DI void ret_kv_item(const Params& p, int l, int item, char* smem) {
  const int tid = get_tid(), lane = tid & 63, w = tid >> 6, r = lane & 31, h = lane >> 5;
  const int hd = item & 3, s = item >> 2;
  const bool sample = s >= 32;
  const int n = sample ? ((s - 32) & 15) : (s & 1);
  const int m0 = s * 128;
  u16* vT = (u16*)smem; u16* kT = (u16*)(smem + 32768);
  const u16* zrl = (const u16*)(p.ws + OFF_ZRL);
  const float lgf = logsig(p.in[I_RLOGIT][(l * 2 + 0) * 4 + hd]), lgb = logsig(p.in[I_RLOGIT][(l * 2 + 1) * 4 + hd]);
  uint4 va[4], vb[4];
#pragma unroll
  for (int it = 0; it < 4; ++it) {
    int pidx = it * 256 + tid, jp = pidx & 63, fg = pidx >> 6;
    const u16* sp = zrl + (size_t)(m0 + 2 * jp) * ZRL_LD + 1024 + hd * 128 + fg * 8;
    va[it] = *(const uint4*)sp; vb[it] = *(const uint4*)(sp + ZRL_LD);
  }
  RopeRaw rr[4];
#pragma unroll
  for (int q4 = 0; q4 < 4; ++q4) { int hb = q4 >> 1, i2 = q4 & 1; int pidx = hb * 256 + tid, jp = pidx & 63, fg = pidx >> 6; int j = 2 * jp + i2; rope_load(p, zrl + (size_t)(m0 + j) * ZRL_LD + 512 + hd * 128, fg * 8, sample, n * 128 + j, rr[q4]); }
#pragma unroll
  for (int it = 0; it < 4; ++it) {
    int pidx = it * 256 + tid, jp = pidx & 63, fg = pidx >> 6;
#pragma unroll
    for (int q = 0; q < 8; ++q) *(unsigned*)(vT + swz(fg * 8 + q, 2 * jp)) = pair16(va[it], vb[it], q);
  }
  uint4 kpa[4], kpb[4];
#pragma unroll
  for (int q4 = 0; q4 < 4; ++q4) { float a[8], b[8]; rope_finish(rr[q4], sample, a, b); kpa[q4] = pack8(a); kpb[q4] = pack8(b); }
  _Pragma("unroll 1")
  for (int dir = 0; dir < 2; ++dir) {
    int tl = tid; asm volatile("" : "+v"(tl));
#pragma unroll
    for (int it = 0; it < 2; ++it) {
      int pidx = it * 256 + tl, jp = pidx & 63, fg = pidx >> 6, j = 2 * jp;
      float w0 = 0.08838834764831845f * (dir == 0 ? __expf((float)(127 - j) * lgf) : __expf((float)j * lgb));
      float w1 = 0.08838834764831845f * (dir == 0 ? __expf((float)(126 - j) * lgf) : __expf((float)(j + 1) * lgb));
      float a0[8], b0[8], a1[8], b1[8];
      unpack8(kpa[it * 2], a0); unpack8(kpb[it * 2], b0); unpack8(kpa[it * 2 + 1], a1); unpack8(kpb[it * 2 + 1], b1);
#pragma unroll
      for (int q = 0; q < 8; ++q) {
        *(unsigned*)(kT + swz(fg * 8 + q, j)) = pack2(a0[q] * w0, a1[q] * w1);
        *(unsigned*)(kT + swz(64 + fg * 8 + q, j)) = pack2(b0[q] * w0, b1[q] * w1);
      }
    }
    __syncthreads();
    f32x16 acc[4];
#pragma unroll
    for (int ct = 0; ct < 4; ++ct) acc[ct] = zero16();
#pragma unroll
    for (int ks = 0; ks < 8; ++ks) {
      bf16x8 a = ldfrag(kT, 32 * w + r, ks * 16 + 8 * h);
#pragma unroll
      for (int ct = 0; ct < 4; ++ct) { bf16x8 b = ldfrag(vT, 32 * ct + r, ks * 16 + 8 * h); acc[ct] = mfma32(a, b, acc[ct]); }
    }
    u16* kv = (u16*)(p.ws + OFF_KV) + (size_t)((s * 4 + hd) * 2 + dir) * 16384;
#pragma unroll
    for (int ct = 0; ct < 4; ++ct)
#pragma unroll
      for (int g = 0; g < 4; ++g) {
        int e = 32 * ct + r, d0 = 32 * w + 8 * g + 4 * h;
        uint2 o; o.x = pack2(acc[ct][4 * g], acc[ct][4 * g + 1]); o.y = pack2(acc[ct][4 * g + 2], acc[ct][4 * g + 3]);
        *(uint2*)(kv + e * 128 + d0) = o;
      }
    __syncthreads();
  }
}

DI void ret_scan_item(const Params& p, int l, int item) {
  const int tid = get_tid();
  u16* kvb = (u16*)(p.ws + OFF_KV);
  if (item < 256) {
    const int part = item & 7, dir = (item >> 3) & 1, hd = (item >> 4) & 3, b = item >> 6;
    const int pidx = part * 256 + tid, cch = pidx & 15, e = pidx >> 4, d0 = cch * 8;
    const float dec = __expf(128.f * logsig(p.in[I_RLOGIT][(l * 2 + dir) * 4 + hd]));
    float R[8];
    const float* s0 = p.in[I_SRET] + ((((size_t)(b * 2 + l) * 2 + dir) * 4 + hd) * 128 + d0) * 128 + e;
#pragma unroll
    for (int q = 0; q < 8; ++q) R[q] = s0[q * 128];
    const int slot0 = 32 + b * 16;
    uint4 kvv[16];
#pragma unroll
    for (int n = 0; n < 16; ++n) kvv[n] = *(const uint4*)(kvb + (size_t)(((slot0 + n) * 4 + hd) * 2 + dir) * 16384 + e * 128 + d0);
#pragma unroll
    for (int i = 0; i < 16; ++i) {
      const int n = dir == 0 ? i : 15 - i;
      uint4 cur = dir == 0 ? kvv[i] : kvv[15 - i];
      *(uint4*)(kvb + (size_t)(((slot0 + n) * 4 + hd) * 2 + dir) * 16384 + e * 128 + d0) = pack8(R);
      float f[8]; unpack8(cur, f);
#pragma unroll
      for (int q = 0; q < 8; ++q) R[q] = dec * R[q] + f[q];
    }
  } else {
    const int it2 = item - 256;
    const int part = it2 & 7, dir = (it2 >> 3) & 1, hd = (it2 >> 4) & 3, b = it2 >> 6;
    const int pidx = part * 256 + tid, e = pidx & 127, cch = pidx >> 7, d0 = cch * 8;
    const float dec = __expf(128.f * logsig(p.in[I_RLOGIT][(l * 2 + dir) * 4 + hd]));
    const int slot0 = b * 2;
    u16* k0 = kvb + (size_t)(((slot0 + 0) * 4 + hd) * 2 + dir) * 16384 + e * 128 + d0;
    u16* k1 = kvb + (size_t)(((slot0 + 1) * 4 + hd) * 2 + dir) * 16384 + e * 128 + d0;
    uint4 v0 = *(const uint4*)k0, v1 = *(const uint4*)k1;
    float f0[8], f1[8]; unpack8(v0, f0); unpack8(v1, f1);
    float* o = p.out + OUT_SRET + ((((size_t)(b * 2 + l) * 2 + dir) * 4 + hd) * 128 + d0) * 128 + e;
    const uint4 zz = make_uint4(0u, 0u, 0u, 0u);
    if (dir == 0) {
      *(uint4*)k0 = zz; *(uint4*)k1 = v0;
#pragma unroll
      for (int q = 0; q < 8; ++q) __builtin_nontemporal_store(dec * f0[q] + f1[q], o + q * 128);
    } else {
      *(uint4*)k1 = zz; *(uint4*)k0 = v1;
#pragma unroll
      for (int q = 0; q < 8; ++q) __builtin_nontemporal_store(dec * f1[q] + f0[q], o + q * 128);
    }
  }
}

DI void lru_scan_item(const Params& p, int l, int item) {
  const int tid = get_tid();
  const int gidx = item * 256 + tid;
  const int W = gidx & 511, dir = (gidx >> 9) & 1, seq = gidx >> 10;
  const bool ctx = seq < 16;
  const int b = ctx ? seq : seq - 16;
  const int N = ctx ? 4 : 32, slot0 = ctx ? b * 4 : 64 + b * 32;
  float* sums = (float*)(p.ws + OFF_LRUS);
  float cA[32], cB[32];
#pragma unroll
  for (int m = 0; m < 32; ++m) {
    int mc = m < N ? m : N - 1;
    cA[m] = sums[((size_t)((slot0 + mc) * 2 + dir) * 2 + 0) * 512 + W]; cB[m] = sums[((size_t)((slot0 + mc) * 2 + dir) * 2 + 1) * 512 + W];
  }
  float c = ctx ? 0.f : p.in[I_SLRU][((b * 2 + l) * 2 + dir) * 512 + W];
  if (dir == 0) {
#pragma unroll
    for (int m = 0; m < 32; ++m) if (m < N) { sums[((size_t)((slot0 + m) * 2 + dir) * 2 + 0) * 512 + W] = c; c = cA[m] * c + cB[m]; }
  } else {
#pragma unroll
    for (int m = 31; m >= 0; --m) if (m < N) { sums[((size_t)((slot0 + m) * 2 + dir) * 2 + 0) * 512 + W] = c; c = cA[m] * c + cB[m]; }
  }
}

DI void ret_out_item(const Params& p, int l, int item, char* smem) {
  const int tid = get_tid(), lane = tid & 63, w = tid >> 6, r = lane & 31, h = lane >> 5;
  const int half = item & 1, hd = (item >> 1) & 3, s = item >> 3;
  const bool sample = s >= 32;
  const int n = sample ? ((s - 32) & 15) : (s & 1);
  const int m0 = s * 128;
  u16* bufQ = (u16*)smem; u16* bufK = (u16*)(smem + 16384); u16* bufP = (u16*)(smem + 49152);
  const u16* zrl = (const u16*)(p.ws + OFF_ZRL);
  const u16* kvbase = (const u16*)(p.ws + OFF_KV);
  const float lgf = logsig(p.in[I_RLOGIT][(l * 2 + 0) * 4 + hd]), lgb = logsig(p.in[I_RLOGIT][(l * 2 + 1) * 4 + hd]);
  {
    RopeRaw rq[2], rk[4];
#pragma unroll
    for (int it = 0; it < 2; ++it) { int pidx = it * 256 + tid, fg = pidx & 7, j = pidx >> 3; rope_load(p, zrl + (size_t)(m0 + 64 * half + j) * ZRL_LD + hd * 128, fg * 8, sample, n * 128 + 64 * half + j, rq[it]); }
#pragma unroll
    for (int it = 0; it < 4; ++it) { int pidx = it * 256 + tid, fg = pidx & 7, j = pidx >> 3; rope_load(p, zrl + (size_t)(m0 + j) * ZRL_LD + 512 + hd * 128, fg * 8, sample, n * 128 + j, rk[it]); }
#pragma unroll
    for (int it = 0; it < 2; ++it) {
      int pidx = it * 256 + tid, fg = pidx & 7, j = pidx >> 3;
      float a[8], bb[8]; rope_finish(rq[it], sample, a, bb);
      *(uint4*)(bufQ + swz(j, fg * 8)) = pack8(a); *(uint4*)(bufQ + swz(j, 64 + fg * 8)) = pack8(bb);
    }
#pragma unroll
    for (int it = 0; it < 4; ++it) {
      int pidx = it * 256 + tid, fg = pidx & 7, j = pidx >> 3;
      float a[8], bb[8]; rope_finish(rk[it], sample, a, bb);
#pragma unroll
      for (int q = 0; q < 8; ++q) { a[q] *= 0.08838834764831845f; bb[q] *= 0.08838834764831845f; }
      *(uint4*)(bufK + swz(j, fg * 8)) = pack8(a); *(uint4*)(bufK + swz(j, 64 + fg * 8)) = pack8(bb);
    }
  }
  uint4 vva[4], vvb[4];
#pragma unroll
  for (int it = 0; it < 4; ++it) {
    int pidx = it * 256 + tid, jp = pidx & 63, fg = pidx >> 6;
    const u16* sp = zrl + (size_t)(m0 + 2 * jp) * ZRL_LD + 1024 + hd * 128 + fg * 8;
    vva[it] = *(const uint4*)sp; vvb[it] = *(const uint4*)(sp + ZRL_LD);
  }
  __syncthreads();
  const int rt = w & 1, cp = w >> 1;
  {
    f32x16 sacc[2]; sacc[0] = zero16(); sacc[1] = zero16();
#pragma unroll
    for (int ks = 0; ks < 8; ++ks) {
      bf16x8 a = ldfrag(bufQ, 32 * rt + r, ks * 16 + 8 * h);
#pragma unroll
      for (int c2 = 0; c2 < 2; ++c2) { bf16x8 bb = ldfrag(bufK, 32 * (2 * cp + c2) + r, ks * 16 + 8 * h); sacc[c2] = mfma32(a, bb, sacc[c2]); }
    }
#pragma unroll
    for (int c2 = 0; c2 < 2; ++c2)
#pragma unroll
      for (int i = 0; i < 16; ++i) {
        int row = 32 * rt + crow(i, h), ig = 64 * half + row, j = 32 * (2 * cp + c2) + r, diff = ig - j;
        float arg = diff > 0 ? (float)diff * lgf : (float)(-diff) * lgb;
        float wgt = __expf(arg); wgt = diff == 0 ? 2.f : wgt;
        bufP[swz(row, j)] = f2bf(sacc[c2][i] * wgt);
      }
  }
  __syncthreads();
#pragma unroll
  for (int it = 0; it < 4; ++it) {
    int pidx = it * 256 + tid, jp = pidx & 63, fg = pidx >> 6;
#pragma unroll
    for (int q = 0; q < 8; ++q) *(unsigned*)(bufK + swz(fg * 8 + q, 2 * jp)) = pair16(vva[it], vvb[it], q);
  }
  u32x32 rv;
#pragma unroll
  for (int it = 0; it < 8; ++it) { int pidx = it * 256 + tid; u32x4 t4 = __builtin_nontemporal_load((const u32x4*)(kvbase + (size_t)((s * 4 + hd) * 2 + 0) * 16384 + pidx * 8)); rv[4 * it] = t4[0]; rv[4 * it + 1] = t4[1]; rv[4 * it + 2] = t4[2]; rv[4 * it + 3] = t4[3]; }
  __syncthreads();
  f32x16 oacc[2]; oacc[0] = zero16(); oacc[1] = zero16();
#pragma unroll
  for (int ks = 0; ks < 8; ++ks) {
    bf16x8 a = ldfrag(bufP, 32 * rt + r, ks * 16 + 8 * h);
#pragma unroll
    for (int c2 = 0; c2 < 2; ++c2) { bf16x8 bb = ldfrag(bufK, 32 * (2 * cp + c2) + r, ks * 16 + 8 * h); oacc[c2] = mfma32(a, bb, oacc[c2]); }
  }
  __syncthreads();
  u32x32 rv1;
#define RET_CROSS(DIR, RCUR)                                                                                                   \
  {                                                                                                                            \
    const float lg = (DIR) == 0 ? lgf : lgb;                                                                                   \
    _Pragma("unroll") for (int it = 0; it < 8; ++it) { int pidx = it * 256 + tid, cch = pidx & 15, e = pidx >> 4; u32x4 t4 = {RCUR[4 * it], RCUR[4 * it + 1], RCUR[4 * it + 2], RCUR[4 * it + 3]}; *(u32x4*)(bufK + swz(e, cch * 8)) = t4; } \
    if ((DIR) == 0) {                                                                                                          \
      _Pragma("unroll") for (int it = 0; it < 8; ++it) { int pidx = it * 256 + tid; u32x4 t4 = __builtin_nontemporal_load((const u32x4*)(kvbase + (size_t)((s * 4 + hd) * 2 + 1) * 16384 + pidx * 8)); rv1[4 * it] = t4[0]; rv1[4 * it + 1] = t4[1]; rv1[4 * it + 2] = t4[2]; rv1[4 * it + 3] = t4[3]; } \
    }                                                                                                                          \
    __syncthreads();                                                                                                           \
    f32x16 cacc[2]; cacc[0] = zero16(); cacc[1] = zero16();                                                                    \
    _Pragma("unroll") for (int ks = 0; ks < 8; ++ks) {                                                                         \
      bf16x8 a = ldfrag(bufQ, 32 * rt + r, ks * 16 + 8 * h);                                                                   \
      _Pragma("unroll") for (int c2 = 0; c2 < 2; ++c2) { bf16x8 bb = ldfrag(bufK, 32 * (2 * cp + c2) + r, ks * 16 + 8 * h); cacc[c2] = mfma32(a, bb, cacc[c2]); } \
    }                                                                                                                          \
    _Pragma("unroll") for (int i = 0; i < 16; ++i) {                                                                           \
      int ig = 64 * half + 32 * rt + crow(i, h);                                                                               \
      float xw = (DIR) == 0 ? __expf((float)(ig + 1) * lg) : __expf((float)(128 - ig) * lg);                                   \
      oacc[0][i] += xw * cacc[0][i]; oacc[1][i] += xw * cacc[1][i];                                                            \
    }                                                                                                                          \
    __syncthreads();                                                                                                           \
  }
  RET_CROSS(0, rv)
  RET_CROSS(1, rv1)
#undef RET_CROSS
  float* red = (float*)(smem + 65536 - 512);
  float* O32 = (float*)(smem + 16384);
  float ss[16];
#pragma unroll
  for (int i = 0; i < 16; ++i) {
    float v = oacc[0][i] * oacc[0][i] + oacc[1][i] * oacc[1][i];
    v += __shfl_xor(v, 1); v += __shfl_xor(v, 2); v += __shfl_xor(v, 4); v += __shfl_xor(v, 8); v += __shfl_xor(v, 16);
    ss[i] = v;
  }
  if (r == 0) {
#pragma unroll
    for (int i = 0; i < 16; ++i) red[cp * 64 + 32 * rt + crow(i, h)] = ss[i];
  }
#pragma unroll
  for (int i = 0; i < 16; ++i) {
    int row = 32 * rt + crow(i, h);
    O32[row * 132 + 32 * (2 * cp) + r] = oacc[0][i]; O32[row * 132 + 32 * (2 * cp + 1) + r] = oacc[1][i];
  }
  uint4 gv[4];
#pragma unroll
  for (int k = 0; k < 4; ++k) { int idx = tid + 256 * k, row = idx >> 4, c16 = idx & 15; gv[k] = *(const uint4*)(zrl + (size_t)(m0 + 64 * half + row) * ZRL_LD + 1536 + hd * 128 + c16 * 8); }
  __syncthreads();
  u16* y = (u16*)(p.ws + OFF_HY);
#pragma unroll
  for (int k = 0; k < 4; ++k) {
    int idx = tid + 256 * k, row = idx >> 4, c16 = idx & 15;
    float rstd = rsqrtf((red[row] + red[64 + row]) * (1.f / 128.f) + EPSF);
    float4 x0 = *(const float4*)(O32 + row * 132 + c16 * 8), x1 = *(const float4*)(O32 + row * 132 + c16 * 8 + 4);
    float g[8]; unpack8(gv[k], g);
    float o[8] = {x0.x, x0.y, x0.z, x0.w, x1.x, x1.y, x1.z, x1.w};
#pragma unroll
    for (int q = 0; q < 8; ++q) o[q] = o[q] * rstd * siluf(g[q]);
    *(uint4*)(y + (size_t)(m0 + 64 * half + row) * DMIX + hd * 128 + c16 * 8) = pack8(o);
  }
  __syncthreads();
}

DI void lru_items(const Params& p, int l, int mode, int first, int last, char* smem) {
  const int tid = get_tid(), lane = tid & 63, w = tid >> 6, r = lane & 31, h = lane >> 5;
  if (first >= last) return;
  const int blk = first & 7;
  u16* ubf = (u16*)smem;
  float* X = (float*)(smem + 8192);
  float* Y = X + 64 * 65;
  float* Z = Y + 64 * 65;
  float* seg = Z + 64 * 65;
  const u16* zrl = (const u16*)(p.ws + OFF_ZRL);
  const int c8 = tid & 7, W0 = blk * 64 + c8 * 8;
  float* cwl = seg + 512;
  for (int idx = tid; idx < 320; idx += 256) cwl[idx] = idx < 256 ? p.in[I_LCW][(l * 4 + (idx >> 6)) * 512 + blk * 64 + (idx & 63)] : p.in[I_LCB][l * 512 + blk * 64 + (idx - 256)];
  __syncthreads();
#define LRU_LOADZ(ITEM)                                                                                                        \
  {                                                                                                                            \
    const int s_ = (ITEM) >> 3; const bool ctx_ = s_ < 64; const int n_ = ctx_ ? (s_ & 3) : ((s_ - 64) & 31);                    \
    const int L_ = ctx_ ? 256 : 2048, t0_ = n_ * 64, mseq_ = s_ * 64 - t0_;                                                     \
    _Pragma("unroll") for (int it = 0; it < 2; ++it)                                                                           \
      _Pragma("unroll") for (int j = 0; j < 4; ++j) {                                                                          \
        int t = (it * 256 + tid) >> 3; int pos = t0_ + t + j - 2; int pc = pos < 0 ? 0 : (pos >= L_ ? L_ - 1 : pos);            \
        u32x4 t4 = *(const u32x4*)(zrl + (size_t)(mseq_ + pc) * ZRL_LD + 2048 + W0);                                           \
        zv[(it * 4 + j) * 4] = t4[0]; zv[(it * 4 + j) * 4 + 1] = t4[1]; zv[(it * 4 + j) * 4 + 2] = t4[2]; zv[(it * 4 + j) * 4 + 3] = t4[3]; \
      }                                                                                                                        \
  }
  u32x32 zv;
  LRU_LOADZ(first)
  const int mt = w & 1, ntl = w >> 1;
  const int ch = 32 * ntl + r, Wc = blk * 64 + ch;
  const int sch = tid & 63, sg = tid >> 6, Ws = blk * 64 + sch;
  float* sums = (float*)(p.ws + OFF_LRUS);
  bf16x8 gfr[2][2][4]; float gbv[2][2], lamv[2];
#pragma unroll
  for (int dd = 0; dd < 2; ++dd) {
    const u16* gw0 = (const u16*)(p.ws + OFF_GWT) + (size_t)((((l * 2 + dd) * 2 + 0) * 8 + blk)) * 4096 + ch * 64 + 8 * h;
#pragma unroll
    for (int ks = 0; ks < 4; ++ks) { gfr[dd][0][ks] = *(const bf16x8*)(gw0 + ks * 16); gfr[dd][1][ks] = *(const bf16x8*)(gw0 + 8 * 4096 + ks * 16); }
    gbv[dd][0] = p.in[I_LGB][((l * 2 + dd) * 2 + 0) * 512 + Wc]; gbv[dd][1] = p.in[I_LGB][((l * 2 + dd) * 2 + 1) * 512 + Wc];
    lamv[dd] = log1pf(__expf(-p.in[I_LLAM][(l * 2 + dd) * 512 + Wc]));
  }
  _Pragma("unroll 1")
  for (int item = first; item < last; item += gridDim.x) {
  const int s = item >> 3;
  const bool ctx = s < 64;
  const int b = ctx ? (s >> 2) : ((s - 64) >> 5);
  const int n = ctx ? (s & 3) : ((s - 64) & 31);
  const int N = ctx ? 4 : 32, L = ctx ? 256 : 2048;
  const int m0 = s * 64, t0 = n * 64;
  {
#pragma unroll
    for (int it = 0; it < 2; ++it) {
      int t = (it * 256 + tid) >> 3;
      float acc[8];
#pragma unroll
      for (int q = 0; q < 8; ++q) acc[q] = cwl[256 + c8 * 8 + q];
#pragma unroll
      for (int j = 0; j < 4; ++j) {
        int pos = t0 + t + j - 2;
        const unsigned mk = (pos >= 0 && pos < L) ? 0xffffffffu : 0u;
        uint4 zq = make_uint4(zv[(it * 4 + j) * 4] & mk, zv[(it * 4 + j) * 4 + 1] & mk, zv[(it * 4 + j) * 4 + 2] & mk, zv[(it * 4 + j) * 4 + 3] & mk);
        float f[8]; unpack8(zq, f);
#pragma unroll
        for (int q = 0; q < 8; ++q) acc[q] += cwl[j * 64 + c8 * 8 + q] * f[q];
      }
      *(uint4*)(ubf + swz64(t, c8 * 8)) = pack8(acc);
    }
  }
  if (item + (int)gridDim.x < last) LRU_LOADZ(item + (int)gridDim.x)
  __syncthreads();
#define LRU_DIR(DIR, Bb)                                                                                                       \
  {                                                                                                                            \
    const float gc0 = -1.4426950408889634f * gbv[DIR][0], gc1 = -1.4426950408889634f * gbv[DIR][1];                            \
    const float sp8l = -8.f * 1.4426950408889634f * lamv[DIR], sp16 = -16.f * lamv[DIR];                                       \
    float hc0 = 0.f;                                                                                                           \
    if (mode == 1) hc0 = sums[((size_t)(s * 2 + (DIR)) * 2 + 0) * 512 + Ws];                                                   \
    f32x16 g0 = zero16(), g1 = zero16();                                                                                       \
    _Pragma("unroll") for (int ks = 0; ks < 4; ++ks) {                                                                         \
      bf16x8 a = *(const bf16x8*)(ubf + swz64(32 * mt + r, ks * 16 + 8 * h));                                                  \
      g0 = mfma32(a, gfr[DIR][0][ks], g0); g1 = mfma32(a, gfr[DIR][1][ks], g1);                                                \
    }                                                                                                                          \
    u16 uraw[16];                                                                                                              \
    _Pragma("unroll") for (int i = 0; i < 16; ++i) uraw[i] = ubf[swz64(32 * mt + crow(i, h), ch)];                             \
    _Pragma("unroll") for (int i = 0; i < 16; ++i) {                                                                           \
      int t = 32 * mt + crow(i, h);                                                                                            \
      float rr = __builtin_amdgcn_rcpf(1.f + __builtin_amdgcn_exp2f(fmaf(g0[i], -1.4426950408889634f, gc0)));                  \
      float ii = __builtin_amdgcn_rcpf(1.f + __builtin_amdgcn_exp2f(fmaf(g1[i], -1.4426950408889634f, gc1)));                  \
      float av = __builtin_amdgcn_exp2f(rr * sp8l);                                                                            \
      float x2 = rr * sp16;                                                                                                    \
      float e2 = -x2 * (1.f + x2 * (0.5f + x2 * (0.16666667f + x2 * 0.041666668f)));                                           \
      float e1 = fmaf(-av, av, 1.f);                                                                                           \
      float em = x2 > -0.25f ? e2 : e1;                                                                                        \
      float uv = bf2f(uraw[i]);                                                                                                \
      X[t * 65 + ch] = av; Bb[t * 65 + ch] = __builtin_amdgcn_sqrtf(em) * (ii * uv);                                           \
    }                                                                                                                          \
    __syncthreads();                                                                                                           \
    {                                                                                                                          \
      float A = 1.f, Bv = 0.f;                                                                                                 \
      if ((DIR) == 0) { _Pragma("unroll") for (int t = 0; t < 16; ++t) { int tt = sg * 16 + t; float a = X[tt * 65 + sch]; Bv = a * Bv + Bb[tt * 65 + sch]; A *= a; } } \
      else            { _Pragma("unroll") for (int t = 15; t >= 0; --t) { int tt = sg * 16 + t; float a = X[tt * 65 + sch]; Bv = a * Bv + Bb[tt * 65 + sch]; A *= a; } } \
      seg[(0 * 4 + sg) * 64 + sch] = A; seg[(1 * 4 + sg) * 64 + sch] = Bv;                                                     \
    }                                                                                                                          \
    __syncthreads();                                                                                                           \
    if (mode == 0) {                                                                                                           \
      if (sg == 0) {                                                                                                           \
        float A = 1.f, Bv = 0.f;                                                                                               \
        if ((DIR) == 0) { for (int q = 0; q < 4; ++q) { float a = seg[q * 64 + sch]; Bv = a * Bv + seg[(4 + q) * 64 + sch]; A *= a; } } \
        else            { for (int q = 3; q >= 0; --q) { float a = seg[q * 64 + sch]; Bv = a * Bv + seg[(4 + q) * 64 + sch]; A *= a; } } \
        sums[((size_t)(s * 2 + (DIR)) * 2 + 0) * 512 + Ws] = A; sums[((size_t)(s * 2 + (DIR)) * 2 + 1) * 512 + Ws] = Bv;        \
      }                                                                                                                        \
    } else {                                                                                                                   \
      float hc = hc0;                                                                                                          \
      if ((DIR) == 0) {                                                                                                        \
        for (int q = 0; q < sg; ++q) hc = seg[q * 64 + sch] * hc + seg[(4 + q) * 64 + sch];                                    \
        _Pragma("unroll") for (int t = 0; t < 16; ++t) { int tt = sg * 16 + t; hc = X[tt * 65 + sch] * hc + Bb[tt * 65 + sch]; Bb[tt * 65 + sch] = hc; } \
        if (ctx && n == N - 1 && sg == 3) p.out[OUT_SLRU + ((size_t)(b * 2 + l) * 2 + 0) * 512 + Ws] = hc;                     \
      } else {                                                                                                                 \
        for (int q = 3; q > sg; --q) hc = seg[q * 64 + sch] * hc + seg[(4 + q) * 64 + sch];                                    \
        _Pragma("unroll") for (int t = 15; t >= 0; --t) { int tt = sg * 16 + t; hc = X[tt * 65 + sch] * hc + Bb[tt * 65 + sch]; Bb[tt * 65 + sch] = hc; } \
        if (ctx && n == 0 && sg == 0) p.out[OUT_SLRU + ((size_t)(b * 2 + l) * 2 + 1) * 512 + Ws] = hc;                          \
      }                                                                                                                        \
    }                                                                                                                          \
    __syncthreads();                                                                                                           \
  }
  LRU_DIR(0, Y)
  LRU_DIR(1, Z)
#undef LRU_DIR
  if (mode == 1) {
    u16* y = (u16*)(p.ws + OFF_HY);
    uint4 gv[2];
#pragma unroll
    for (int it = 0; it < 2; ++it) { int pidx = it * 256 + tid, c8 = pidx & 7, t = pidx >> 3; gv[it] = *(const uint4*)(zrl + (size_t)(m0 + t) * ZRL_LD + 2048 + 512 + blk * 64 + c8 * 8); }
#pragma unroll
    for (int it = 0; it < 2; ++it) {
      int pidx = it * 256 + tid, c8 = pidx & 7, t = pidx >> 3;
      float g[8], o[8]; unpack8(gv[it], g);
#pragma unroll
      for (int q = 0; q < 8; ++q) o[q] = (Y[t * 65 + c8 * 8 + q] + Z[t * 65 + c8 * 8 + q]) * siluf(g[q]);
      *(uint4*)(y + (size_t)(m0 + t) * DMIX + 1024 + blk * 64 + c8 * 8) = pack8(o);
    }
    __syncthreads();
  }
  }
#undef LRU_LOADZ
}

template <int L, int B>
DI void hyena_item(const Params& p, int l, int c, char* smem) {
  constexpr int NB = L / 32, IPG = 32 / B, NG = NB / IPG, GPW = NG / 4, PADB = IPG - 1;
  constexpr int UROW = (B == 4) ? 2568 : 392;
  constexpr int MBASE = (B == 4) ? MCTX : 0;
  constexpr int ROWB = (B == 4) ? 256 : 0;
  const int tid = get_tid(), lane = tid & 63, w = __builtin_amdgcn_readfirstlane(tid >> 6), r = lane & 31, h = lane >> 5;
  u16* TR0 = (u16*)smem;
  u16* TR1 = TR0 + 2 * L + 32;
  u16* U = TR1 + 2 * L + 32;
  u16* X1 = U + B * UROW;
  const u16* zt = (const u16*)(p.ws + OFF_ZT);
  constexpr int NIT = B * L / 8 / 256;
  constexpr int NK = L / 256;
  uint4 sv0[NIT], sv1[NIT]; u16 sl0[NIT], sr0[NIT], sl1[NIT], sr1[NIT];
  u16 fvf[2][NK], fvb[2][NK]; float fhf0[2], fbias[2], fsf[2], fsb[2];
#define STG_LOAD(CHAN, V, LF, RT)                                                                     \
  {                                                                                                   \
    const u16* src_ = zt + (size_t)(CHAN) * MTOK + MBASE;                                             \
    _Pragma("unroll") for (int k = 0; k < NIT; ++k) {                                                 \
      int idx = tid + 256 * k; int bb = idx / (L / 8), t8 = (idx % (L / 8)) * 8;                      \
      const u16* sp = src_ + bb * L + t8;                                                             \
      { u32x4 t4 = __builtin_nontemporal_load((const u32x4*)sp); V[k] = make_uint4(t4[0], t4[1], t4[2], t4[3]); } LF[k] = sp[t8 > 0 ? -1 : 0]; RT[k] = sp[(t8 + 8 < L) ? 8 : 7]; \
    }                                                                                                 \
  }
#define STG_WRITE(CHAN, V, LF, RT, DST, RSTRIDE, ROFF)                                                \
  {                                                                                                   \
    const float w0 = p.in[I_HCW][(l * 3 + 0) * 1536 + (CHAN)], w1 = p.in[I_HCW][(l * 3 + 1) * 1536 + (CHAN)], w2 = p.in[I_HCW][(l * 3 + 2) * 1536 + (CHAN)]; \
    const float bs = p.in[I_HCB][l * 1536 + (CHAN)];                                                  \
    _Pragma("unroll") for (int k = 0; k < NIT; ++k) {                                                 \
      int idx = tid + 256 * k; int bb = idx / (L / 8), t8 = (idx % (L / 8)) * 8;                      \
      float f[10]; unpack8(V[k], f + 1);                                                              \
      f[0] = t8 > 0 ? bf2f(LF[k]) : 0.f; f[9] = (t8 + 8 < L) ? bf2f(RT[k]) : 0.f;                     \
      float o[8];                                                                                     \
      _Pragma("unroll") for (int q = 0; q < 8; ++q) o[q] = w0 * f[q] + w1 * f[q + 1] + w2 * f[q + 2] + bs; \
      *(uint4*)((DST) + bb * (RSTRIDE) + (ROFF) + t8) = pack8(o);                                     \
    }                                                                                                 \
  }
  STG_LOAD(c, sv0, sl0, sr0)
  STG_LOAD(512 + c, sv1, sl1, sr1)
#pragma unroll
  for (int oo = 0; oo < 2; ++oo) {
    const u16* hf = (const u16*)(p.ws + OFF_FILT) + ((size_t)((l * 2 + oo) * 2 + 0) * 512 + c) * 2304 + ROWB;
    const u16* hb = hf + (size_t)512 * 2304;
    const float* cs = (const float*)(p.ws + OFF_CSUM) + (l * 2 + (B == 4 ? 1 : 0)) * 2048 + oo * 1024 + c;
#pragma unroll
    for (int k = 0; k < NK; ++k) { int mx = L - tid - 256 * k; fvf[oo][k] = hf[mx < L ? mx : 0]; fvb[oo][k] = hb[tid + 256 * k]; }
    fhf0[oo] = bf2f(hf[0]); fbias[oo] = p.in[I_HBIAS][(l * 2 + oo) * 512 + c];
    fsf[oo] = cs[0]; fsb[oo] = cs[512];
  }
  STG_WRITE(c, sv0, sl0, sr0, U, UROW, PADB * 32)
  STG_WRITE(512 + c, sv1, sl1, sr1, X1, L, 0)
#undef STG_LOAD
#undef STG_WRITE
  if (PADB > 0) {
    for (int idx = tid; idx < B * PADB * 32 * 2; idx += 256) {
      int bb = idx / (PADB * 64), q = idx % (PADB * 64);
      int off = q < PADB * 32 ? q : (PADB * 32 + L + (q - PADB * 32));
      U[bb * UROW + off] = 0;
    }
  }
  f32x16 acc[GPW];
  const u16* tbase = (r & 1) ? (TR1 - 1) : TR0;
  uint2 xva[GPW][4], gva[GPW][4]; u16 lfa[GPW][4], rta[GPW][4];
  _Pragma("unroll")
  for (int ord = 0; ord < 2; ++ord) {
    {
      const float sf = 1.f / (fsf[ord] + EPSF), sb = 1.f / (fsb[ord] + EPSF);
      const float hf0 = fhf0[ord], bias = fbias[ord];
#pragma unroll
      for (int k = 0; k < NK; ++k) {
        int idx = tid + 256 * k;
        u16 v = (idx == 0) ? (u16)0 : f2bf(bf2f(fvf[ord][k]) * sf);
        TR0[idx] = v; if (idx > 0) TR1[idx - 1] = v;
        int idx2 = L + tid + 256 * k;
        u16 v2 = (idx2 == L) ? f2bf(hf0 * sf + bf2f(fvb[ord][k]) * sb + bias) : f2bf(bf2f(fvb[ord][k]) * sb);
        TR0[idx2] = v2; TR1[idx2 - 1] = v2;
        if (idx2 == 2 * L - 1) TR1[idx2] = 0;
      }
    }
    __syncthreads();
#pragma unroll
    for (int gi = 0; gi < GPW; ++gi) acc[gi] = zero16();
    const int g0 = w * GPW;
    const int dmin = IPG * g0 - (NB - 1), dmax = IPG * (g0 + GPW - 1) + IPG - 1;
    const int nb_ = r % B, il = r / B;
    auto lda = [&](int d, uint4& a0, uint4& a1) {
      const unsigned* ap = (const unsigned*)(tbase + (L + 8 * h - r - 32 * d));
      a0 = make_uint4(ap[0], ap[1], ap[2], ap[3]);
      a1 = make_uint4(ap[8], ap[9], ap[10], ap[11]);
    };
    const u16* ub = U + nb_ * UROW + (PADB + IPG * g0 + il) * 32 + 8 * h;
    struct Fr { uint4 a0, a1; bf16x8 b00, b01, b10, b11; };
    auto ldall = [&](int d, Fr& f) {
      lda(d, f.a0, f.a1);
      const u16* up = ub - 32 * d;
      f.b00 = *(const bf16x8*)(up); f.b01 = *(const bf16x8*)(up + 16);
      if (GPW > 1) { f.b10 = *(const bf16x8*)(up + IPG * 32); f.b11 = *(const bf16x8*)(up + IPG * 32 + 16); }
    };
    if (ord == 1) {
      const u16* gsrc_ = zt + (size_t)(1536 + c) * MTOK + MBASE + nb_ * L;
      const u16* xsrc_ = zt + (size_t)(1024 + c) * MTOK + MBASE + nb_ * L;
      const int tbp = 32 * (IPG * g0 + il) + 4 * h;
#pragma unroll
      for (int gi = 0; gi < GPW; ++gi)
#pragma unroll
        for (int g4 = 0; g4 < 4; ++g4) {
          int tq = tbp + 32 * IPG * gi + 8 * g4;
          xva[gi][g4] = *(const uint2*)(xsrc_ + tq); gva[gi][g4] = *(const uint2*)(gsrc_ + tq);
          lfa[gi][g4] = xsrc_[tq > 0 ? tq - 1 : 0]; rta[gi][g4] = xsrc_[(tq + 4 < L) ? tq + 4 : tq];
        }
    }
    Fr X, Y;
    ldall(dmin, X);
    auto step = [&](int d, const Fr& cur, Fr& nxt, auto act0, auto act1) {
      ldall(d < dmax ? d + 1 : dmax, nxt);
      __builtin_amdgcn_sched_barrier(0);
      bf16x8 a0 = __builtin_bit_cast(bf16x8, cur.a0), a1 = __builtin_bit_cast(bf16x8, cur.a1);
      if (act0.value) { acc[0] = mfma32(a0, cur.b00, acc[0]); acc[0] = mfma32(a1, cur.b01, acc[0]); }
      if (GPW > 1 && act1.value) { acc[GPW - 1] = mfma32(a0, cur.b10, acc[GPW - 1]); acc[GPW - 1] = mfma32(a1, cur.b11, acc[GPW - 1]); }
      __builtin_amdgcn_sched_barrier(0);
    };
    auto segment = [&](int lo, int hi, auto act0, auto act1) {
      int d = lo;
      _Pragma("unroll 1") for (; d + 1 <= hi; d += 2) { step(d, X, Y, act0, act1); step(d + 1, Y, X, act0, act1); }
      if (d <= hi) { step(d, X, Y, act0, act1); X = Y; }
    };
    using T1 = std::integral_constant<bool, true>; using T0 = std::integral_constant<bool, false>;
    if (GPW > 1) {
      const int lo1 = IPG * (g0 + 1) - (NB - 1), hi0 = IPG * g0 + IPG - 1;
      segment(dmin, lo1 - 1, T1{}, T0{});
      segment(lo1, hi0, T1{}, T1{});
      segment(hi0 + 1, dmax, T0{}, T1{});
    } else {
      segment(dmin, dmax, T1{}, T0{});
    }
    __syncthreads();
    int tb = 32 * (IPG * g0 + il) + 4 * h;
    asm volatile("" : "+v"(tb));
    if (ord == 0) {
#pragma unroll
      for (int gi = 0; gi < GPW; ++gi)
#pragma unroll
        for (int i = 0; i < 16; ++i) {
          int t = tb + 32 * IPG * gi + (i & 3) + 8 * (i >> 2);
          U[nb_ * UROW + PADB * 32 + t] = f2bf(bf2f(X1[nb_ * L + t]) * acc[gi][i]);
          if ((i & 3) == 3) asm volatile("" ::: "memory");
        }
    } else {
      u16* y = (u16*)(p.ws + OFF_YT);
      const u16* gsrc = zt + (size_t)(1536 + c) * MTOK + MBASE + nb_ * L;
      const u16* xsrc = zt + (size_t)(1024 + c) * MTOK + MBASE + nb_ * L;
      const int chan = 1024 + c;
      const float w0 = p.in[I_HCW][(l * 3 + 0) * 1536 + chan], w1 = p.in[I_HCW][(l * 3 + 1) * 1536 + chan], w2 = p.in[I_HCW][(l * 3 + 2) * 1536 + chan];
      const float bs = p.in[I_HCB][l * 1536 + chan];
#pragma unroll
      for (int gi = 0; gi < GPW; ++gi)
#pragma unroll
        for (int g4 = 0; g4 < 4; ++g4) {
          int tq = tb + 32 * IPG * gi + 8 * g4;
          uint2 xv = xva[gi][g4], gv = gva[gi][g4];
          float f[6];
          f[0] = tq > 0 ? bf2f(lfa[gi][g4]) : 0.f; f[5] = (tq + 4 < L) ? bf2f(rta[gi][g4]) : 0.f;
          f[1] = __uint_as_float(xv.x << 16); f[2] = __uint_as_float(xv.x & 0xffff0000u);
          f[3] = __uint_as_float(xv.y << 16); f[4] = __uint_as_float(xv.y & 0xffff0000u);
          float gg[4] = {__uint_as_float(gv.x << 16), __uint_as_float(gv.x & 0xffff0000u), __uint_as_float(gv.y << 16), __uint_as_float(gv.y & 0xffff0000u)};
          float o[4];
#pragma unroll
          for (int q = 0; q < 4; ++q) {
            float x2 = bf2f(f2bf(w0 * f[q] + w1 * f[q + 1] + w2 * f[q + 2] + bs));
            o[q] = x2 * acc[gi][4 * g4 + q] * siluf(gg[q]);
          }
          uint2 o2; o2.x = pack2(o[0], o[1]); o2.y = pack2(o[2], o[3]);
          *(uint2*)(y + (size_t)c * MTOK + MBASE + nb_ * L + tq) = o2;
        }
    }
  }
  __syncthreads();
}

DI void ytrans_item(const Params& p, int item, char* smem) {
  const int tid = get_tid();
  u16* tile = (u16*)smem;
  const int ct = item & 7, mt = item >> 3;
  const u16* src = (const u16*)(p.ws + OFF_YT) + (size_t)(ct * 64) * MTOK + mt * 64;
  u16* y = (u16*)(p.ws + OFF_HY) + (size_t)(mt * 64) * DMIX + 512 + ct * 64;
  uint4 v[2];
#pragma unroll
  for (int k = 0; k < 2; ++k) { int idx = tid + 256 * k; int cr = idx >> 3, ch8 = idx & 7; u32x4 t4 = __builtin_nontemporal_load((const u32x4*)(src + (size_t)cr * MTOK + ch8 * 8)); v[k] = make_uint4(t4[0], t4[1], t4[2], t4[3]); }
#pragma unroll
  for (int k = 0; k < 2; ++k) {
    int idx = tid + 256 * k; int cr = idx >> 3, ch8 = idx & 7;
#pragma unroll
    for (int q = 0; q < 8; ++q) tile[(ch8 * 8 + q) * 72 + cr] = get16(v[k], q);
  }
  __syncthreads();
#pragma unroll
  for (int k = 0; k < 2; ++k) {
    int idx = tid + 256 * k; int t = idx >> 3, c8 = idx & 7;
    *(uint4*)(y + (size_t)t * DMIX + c8 * 8) = *(const uint4*)(tile + t * 72 + c8 * 8);
  }
  __syncthreads();
}

DI void phase3a(const Params& p, int l, char* smem) {
  constexpr int N0 = 512, N1 = N0 + 384, N2 = N1 + 512, N3 = N2 + 1536;
#ifndef IM
#define IM 0xff
#endif
#ifndef REPI
#define REPI 0
#endif
  for (int item = blockIdx.x; item < N2; item += gridDim.x) {
    int cls = item < N0 ? 0 : item < N1 ? 1 : 2;
    int nr = ((REPI >> cls) & 1) ? 2 : 1;
    for (int rp = 0; rp < nr; ++rp) {
      if (item < N0) { if (IM & 1) hyena_item<2048, 4>(p, l, item, smem); }
      else if (item < N1) { if (IM & 2) ret_kv_item(p, l, item - N0, smem); }
      else { if (IM & 4) hyena_item<256, 16>(p, l, item - N1, smem); }
    }
  }
  {
    int first = blockIdx.x; while (first < N2) first += gridDim.x;
    const int nr = ((REPI >> 3) & 1) ? 2 : 1;
    for (int rp = 0; rp < nr; ++rp) if (IM & 8) lru_items(p, l, 0, first - N2, N3 - N2, smem);
  }
}
DI void phase3b(const Params& p, int l, char* smem) {
  constexpr int N0 = 768, N1 = N0 + 1536, N2 = N1 + 1536;
  for (int item = blockIdx.x; item < N0; item += gridDim.x) {
    int nr = ((REPI >> 4) & 1) ? 2 : 1;
    for (int rp = 0; rp < nr; ++rp) { if (IM & 16) ret_out_item(p, l, item, smem); }
  }
  int first = blockIdx.x; while (first < N0) first += gridDim.x;
  {
    const int nr = ((REPI >> 5) & 1) ? 2 : 1;
    for (int rp = 0; rp < nr; ++rp) if (IM & 32) lru_items(p, l, 1, first - N0, N1 - N0, smem);
  }
  while (first < N1) first += gridDim.x;
  for (int item = first; item < N2; item += gridDim.x) {
    int nr = ((REPI >> 6) & 1) ? 2 : 1;
    for (int rp = 0; rp < nr; ++rp) ytrans_item(p, item - N1, smem);
  }
}

#define XB_TMO      128
#define XB_XCNT(j)  (256  + 64 * (j))
#define XB_XSUB(j)  (1280 + 64 * (j))
#define XB_XGEN(j)  (2304 + 64 * (j))
#define XB_TOP      3328
#define XB_TOPGEN   3392
#define XB_SPIN_CAP (1u << 18)
DI unsigned xb_ld(unsigned* p) { return __hip_atomic_load(p, __ATOMIC_RELAXED, __HIP_MEMORY_SCOPE_AGENT); }
DI unsigned xb_add(unsigned* p, unsigned v) { return __hip_atomic_fetch_add(p, v, __ATOMIC_RELAXED, __HIP_MEMORY_SCOPE_AGENT); }
DI unsigned xb_xcc_id() { return (unsigned)__builtin_amdgcn_s_getreg((3 << 11) | 20) & 0xFu; }
#define XB_SPIN(cond, bar) do { unsigned _sp = 0; while (cond) { __builtin_amdgcn_s_sleep(1); \
    if ((++_sp & 255u) == 0u) { if (xb_ld(&(bar)[XB_TMO])) break; if (_sp > XB_SPIN_CAP) { atomicAdd(&(bar)[XB_TMO], 1u); break; } } } } while (0)
struct XcdBar { unsigned* bar; unsigned x, nloc, nx; };
DI void xcd_complete(unsigned* bar, unsigned x, unsigned& nloc, unsigned& nx) {
  const unsigned G = gridDim.x;
  unsigned sum, cnt, mine, sp = 0u;
  for (;;) {
    sum = 0u; cnt = 0u; mine = 0u;
#pragma unroll
    for (unsigned j = 0; j < 16; ++j) { const unsigned c = xb_ld(&bar[XB_XCNT(j)]); sum += c; cnt += (c > 0u) ? 1u : 0u; mine = (j == x) ? c : mine; }
    if (sum == G) break;
    __builtin_amdgcn_s_sleep(1);
    if ((++sp & 255u) == 0u) { if (xb_ld(&bar[XB_TMO])) break; if (sp > XB_SPIN_CAP) { atomicAdd(&bar[XB_TMO], 1u); break; } }
  }
  nloc = mine > 0u ? mine : 1u; nx = cnt > 0u ? cnt : 1u;
}
DI void xcd_barrier(XcdBar& b) {
  asm volatile("s_waitcnt vmcnt(0)" ::: "memory");
  __syncthreads();
  if (threadIdx.x == 0) {
    unsigned* bar = b.bar;
    __builtin_amdgcn_s_waitcnt(0);
    if (b.nloc == 0u) xcd_complete(bar, b.x, b.nloc, b.nx);
    const unsigned nloc = b.nloc, nx = b.nx;
    const unsigned old = xb_add(&bar[XB_XSUB(b.x)], 1u);
    const unsigned gen = old / nloc;
    if (old + 1u == (gen + 1u) * nloc) {
      __builtin_amdgcn_fence(__ATOMIC_RELEASE, "agent");
      asm volatile("s_waitcnt vmcnt(0)" ::: "memory");
      const unsigned og = xb_add(&bar[XB_TOP], 1u);
      const unsigned tg = og / nx;
      if (og + 1u == (tg + 1u) * nx) xb_add(&bar[XB_TOPGEN], 1u);
      else XB_SPIN(xb_ld(&bar[XB_TOPGEN]) == tg, bar);
      __builtin_amdgcn_fence(__ATOMIC_ACQUIRE, "agent");
      xb_add(&bar[XB_XGEN(b.x)], 1u);
      asm volatile("s_waitcnt vmcnt(0)" ::: "memory");
    } else {
      XB_SPIN(xb_ld(&bar[XB_XGEN(b.x)]) == gen, bar);
      __builtin_amdgcn_fence(__ATOMIC_ACQUIRE, "agent");
      asm volatile("s_waitcnt vmcnt(0)" ::: "memory");
    }
  }
  __syncthreads();
}

constexpr int NPHASE = 14;
#ifndef REPPH
#define REPPH -1
#endif
DI void run_phase(const Params& p, int ph, char* smem) {
  if (ph == 0) {
    for (int idx = blockIdx.x * 256 + threadIdx.x; idx < 2 * 2 * 2048; idx += gridDim.x * 256) ((float*)(p.ws + OFF_CSUM))[idx] = 0.f;
    for (int item = blockIdx.x; item < 1280 + N_MOD; item += gridDim.x) prep_item(p, item < 1280 ? item : PREP_MOD0 + (item - 1280), smem);
  } else if (ph == 1) {
    constexpr int NN = MTOK / 4, NB1 = PREP_MOD0 - 1280, NB2 = N_HID + N_ROPE;
    for (int item = blockIdx.x; item < NN + NB1 + NB2; item += gridDim.x) {
      if (item < NN) norm_item(p, 0, false, item);
      else if (item < NN + NB1) prep_item(p, 1280 + (item - NN), smem);
      else prep_item(p, PREP_MOD0 + N_MOD + (item - NN - NB1), smem);
    }
  } else if (ph == 13) {
    for (int item = blockIdx.x; item < MTOK / 4; item += gridDim.x) norm_item(p, 1, true, item);
  } else {
    const int l = ph >= 8 ? 1 : 0, q = ph >= 8 ? ph - 8 : ph - 2;
    if (ph == 7) { for (int item = blockIdx.x; item < MTOK / 4; item += gridDim.x) norm_item(p, 1, false, item); }
    else if (q == 0) phase_gemm1(p, l, smem);
    else if (q == 1) phase3a(p, l, smem);
    else if (q == 2) { for (int item = blockIdx.x; item < 1280 + 80; item += gridDim.x) { if (item < 1280) ret_scan_item(p, l, item); else lru_scan_item(p, l, item - 1280); } }
    else if (q == 3) phase3b(p, l, smem);
    else phase_gemm2(p, l, smem);
  }
}
__global__ void __launch_bounds__(256, 2) mega(Params p, int ph_lo, int ph_hi, int coop) {
  __shared__ __attribute__((aligned(16))) char smem[65536];
  XcdBar xb; xb.bar = p.bar; xb.x = xb_xcc_id(); xb.nloc = 0u; xb.nx = 0u;
  if (coop) { if (threadIdx.x == 0) (void)xb_add(&p.bar[XB_XCNT(xb.x)], 1u); }
  if (coop == 2) cg::this_grid().sync();
  for (int ph = ph_lo; ph < ph_hi; ++ph) {
    const int nrep = (REPPH >= 0 && ph == REPPH) ? 2 : 1;
    for (int rep = 0; rep < nrep; ++rep) {
      if (rep > 0 && coop) xcd_barrier(xb);
      run_phase(p, ph, smem);
    }
    if (coop && ph + 1 < ph_hi) xcd_barrier(xb);
  }
}

extern "C" void kernel_launch(void* const* d_in, const int* in_sizes, int n_in, void* d_out, int out_size,
                              void* d_ws, size_t ws_size, hipStream_t stream) {
  static int grid_blocks = 0;
  if (!grid_blocks) {
    int dev = 0, cus = 0, per_cu = 0;
    hipGetDevice(&dev);
    hipDeviceGetAttribute(&cus, hipDeviceAttributeMultiprocessorCount, dev);
    hipOccupancyMaxActiveBlocksPerMultiprocessor(&per_cu, mega, 256, 0);
    if (per_cu < 1) per_cu = 1;
    if (per_cu > 2) per_cu = 2;
    grid_blocks = cus * per_cu;
  }
  Params p{};
  for (int i = 0; i < 27; ++i) p.in[i] = (const float*)d_in[i];
  p.out = (float*)d_out; p.ws = (char*)d_ws; p.bar = (unsigned*)((char*)d_ws + OFF_BAR);
  (void)hipMemsetAsync((char*)d_ws + OFF_BAR, 0, BAR_BYTES, stream);
  if (ws_size < WS_TOTAL) fprintf(stderr, "workspace too small: %zu < %zu\n", ws_size, (size_t)WS_TOTAL);
#if COOP
  int lo = 0, hi = NPHASE, coop = 1;
  void* args[] = {&p, &lo, &hi, &coop};
  hipError_t e = hipLaunchCooperativeKernel((void*)mega, dim3(grid_blocks), dim3(256), args, 0, stream);
  if (e != hipSuccess) fprintf(stderr, "cooperative launch failed: %s (grid %d)\n", hipGetErrorString(e), grid_blocks);
#else
  for (int ph = 0; ph < NPHASE; ++ph) hipLaunchKernelGGL(mega, dim3(grid_blocks), dim3(256), 0, stream, p, ph, ph + 1, 0);
#endif
}
```
